# Optimizing an MI355X kernel written in HIP

```python
import math
import jax, jax.numpy as jnp
from jax import lax
import numpy as np

D_MODEL = 1024
BATCH = 8
SEQ = 2048
DEPTH = 1
DEC_BATCH = 128
DEC_SEQ = 8
PAST_LEN = 16384
PAGE_SIZE = 128

SSM_EXPAND = 2
SSM_D_INNER = SSM_EXPAND * D_MODEL
SSM_HEAD_DIM = 64
SSM_HEADS = SSM_D_INNER // SSM_HEAD_DIM
SSM_GROUPS = 4
SSM_STATE = 128
SSM_CONV = 4
SSM_CHUNK = 128
SSM_CONV_DIM = SSM_D_INNER + 2 * SSM_GROUPS * SSM_STATE
RWKV_HEAD_DIM = 64
RWKV_DIM = D_MODEL
RWKV_HEADS = RWKV_DIM // RWKV_HEAD_DIM
W_LORA = 64
A_LORA = 64
G_LORA = 128
RWKV_SHIFT_DIM = 3 * RWKV_DIM + W_LORA + A_LORA + G_LORA
D_FF = 2816
FFN_CONV = 3
IN_DIM = SSM_D_INNER + SSM_CONV_DIM + SSM_HEADS + RWKV_SHIFT_DIM + 2 * D_MODEL
NORM_EPS = 1e-5
GN_EPS = 64e-5

kernel_name = 'hybrid_ssd_rwkv7_convglu_step'


def _rmsnorm(x, g):
    xf = x.astype(jnp.float32)
    y = xf * lax.rsqrt(jnp.mean(xf * xf, axis=-1, keepdims=True) + NORM_EPS)
    return (y * g.astype(jnp.float32)).astype(x.dtype)


def _causal_dwconv(u, buf, w, b):
    L = u.shape[1]
    K = w.shape[0]
    full = jnp.concatenate([buf.astype(u.dtype), u], axis=1)
    out = full[:, 0:L] * w[0]
    for j in range(1, K):
        out = out + full[:, j:j + L] * w[j]
    return out + b, full[:, full.shape[1] - (K - 1):]


def _token_shift(u, buf, mu):
    prev = jnp.concatenate([buf[:, None].astype(u.dtype), u[:, :-1]], axis=1)
    return u + (prev - u) * mu, u[:, -1]


def _ssd(xs, dt, A, Bm, Cm, h0):
    b, L, H, P = xs.shape
    G, N = Bm.shape[2], Bm.shape[3]
    Hg = H // G
    l = math.gcd(L, SSM_CHUNK)
    c = L // l
    xdt = (xs * dt[..., None]).reshape(b, c, l, G, Hg, P)
    cs = jnp.cumsum((dt * A).reshape(b, c, l, G, Hg), axis=2)
    Bc = Bm.reshape(b, c, l, G, N)
    Cc = Cm.reshape(b, c, l, G, N)
    causal = jnp.tril(jnp.ones((l, l), dtype=bool))
    seg = cs[:, :, :, None] - cs[:, :, None, :]
    decay_ls = jnp.exp(jnp.where(causal[None, None, :, :, None, None], seg, -jnp.inf))
    cb = jnp.einsum('bclgn,bcsgn->bclsg', Cc, Bc)
    y_diag = jnp.einsum('bclsgh,bcsghp->bclghp', cb[..., None] * decay_ls, xdt)
    to_end = jnp.exp(cs[:, :, -1:] - cs)
    chunk_states = jnp.einsum('bclgn,bclghp->bcghpn', Bc, xdt * to_end[..., None])
    chunk_decay = jnp.exp(cs[:, :, -1])

    def step(h, inp):
        st, dec = inp
        return h * dec[..., None, None] + st, h

    h_last, h_prev = lax.scan(step, h0.reshape(b, G, Hg, P, N),
                              (jnp.moveaxis(chunk_states, 1, 0), jnp.moveaxis(chunk_decay, 1, 0)))
    h_prev = jnp.moveaxis(h_prev, 0, 1)
    y_off = jnp.einsum('bclgn,bcghpn->bclghp', Cc, h_prev) * jnp.exp(cs)[..., None]
    y = (y_diag + y_off).reshape(b, L, H, P)
    return y, h_last.reshape(b, H, P, N)


def _rwkv7_scan(r, decay, k, v, kk, a, S0):
    def step(S, inp):
        r_t, w_t, k_t, v_t, kk_t, a_t = inp
        sa = jnp.einsum('bhvk,bhk->bhv', S, -kk_t)
        S = (S * w_t[:, :, None, :] + sa[..., None] * (kk_t * a_t)[:, :, None, :]
             + v_t[..., None] * k_t[:, :, None, :])
        return S, jnp.einsum('bhvk,bhk->bhv', S, r_t)

    xs = tuple(jnp.moveaxis(t, 1, 0) for t in (r, decay, k, v, kk, a))
    S, ys = lax.scan(step, S0, xs)
    return jnp.moveaxis(ys, 0, 1), S


def _layer(x, conv_buf, ssm_state, shift_buf, wkv_state, ffn_buf, lp):
    f32 = jnp.float32
    b, L, _ = x.shape
    G, N = SSM_GROUPS, SSM_STATE
    H, K = RWKV_HEADS, RWKV_HEAD_DIM
    h = _rmsnorm(x, lp['norm1_g'])
    proj = h @ lp['w_in']
    o1 = SSM_D_INNER
    o2 = o1 + SSM_CONV_DIM
    o3 = o2 + SSM_HEADS
    o4 = o3 + RWKV_SHIFT_DIM
    z, xbc, dt_raw, rw, gates_raw = jnp.split(proj, [o1, o2, o3, o4], axis=-1)

    xbc_c, new_conv = _causal_dwconv(xbc, conv_buf, lp['ssm_conv_w'], lp['ssm_conv_b'])
    xbc_c = jax.nn.silu(xbc_c.astype(f32))
    xm, Bm, Cm = jnp.split(xbc_c, [SSM_D_INNER, SSM_D_INNER + G * N], axis=-1)
    dt = jax.nn.softplus(dt_raw.astype(f32) + lp['ssm_dt_bias'].astype(f32))
    A = -jnp.exp(lp['ssm_a_log'].astype(f32))
    xm4 = xm.reshape(b, L, SSM_HEADS, SSM_HEAD_DIM)
    ya, new_ssm = _ssd(xm4, dt, A, Bm.reshape(b, L, G, N), Cm.reshape(b, L, G, N),
                       ssm_state.astype(f32))
    ya = ya + lp['ssm_d'].astype(f32)[:, None] * xm4
    ya = ya.reshape(b, L, G, SSM_D_INNER // G) * jax.nn.silu(z.astype(f32)).reshape(b, L, G, SSM_D_INNER // G)
    ya = ya * lax.rsqrt(jnp.mean(ya * ya, axis=-1, keepdims=True) + NORM_EPS)
    ya = ya.reshape(b, L, SSM_D_INNER) * lp['ssm_norm_g'].astype(f32)
    u_a = ya.astype(x.dtype) @ lp['w_branch_a']

    rw_mix, new_shift = _token_shift(rw, shift_buf, lp['rwkv_mu'])
    r, k, v, wl, al, gl = jnp.split(
        rw_mix.astype(f32),
        [RWKV_DIM, 2 * RWKV_DIM, 3 * RWKV_DIM, 3 * RWKV_DIM + W_LORA, 3 * RWKV_DIM + W_LORA + A_LORA],
        axis=-1)
    wlog = -jax.nn.softplus(-(lp['rwkv_w0'] + jnp.tanh(wl) @ lp['rwkv_w_up'])) - 0.5
    decay = jnp.exp(-jnp.exp(wlog.astype(f32)))
    a = jax.nn.sigmoid(lp['rwkv_a0'] + al @ lp['rwkv_a_up']).astype(f32)
    g = (jax.nn.sigmoid(gl) @ lp['rwkv_g_up']).astype(f32)
    hd = lambda t: t.reshape(b, L, H, K)
    kk = hd(k * lp['rwkv_k_k']).astype(f32)
    kk = kk / jnp.maximum(jnp.sqrt(jnp.sum(kk * kk, axis=-1, keepdims=True)), 1e-12)
    k = (k * (1.0 + (a - 1.0) * lp['rwkv_k_a'])).astype(f32)
    r4, k4, v4, a4 = hd(r), hd(k), hd(v), hd(a)
    yb, new_wkv = _rwkv7_scan(r4, hd(decay), k4, v4, kk, a4, wkv_state.astype(f32))
    mu = jnp.mean(yb, axis=-1, keepdims=True)
    var = jnp.mean((yb - mu) ** 2, axis=-1, keepdims=True)
    yb = ((yb - mu) * lax.rsqrt(var + GN_EPS) * lp['rwkv_ln_w'].astype(f32).reshape(H, K)
          + lp['rwkv_ln_b'].astype(f32).reshape(H, K))
    yb = yb + jnp.sum(r4 * k4 * lp['rwkv_r_k'].astype(f32), axis=-1, keepdims=True) * v4
    yb = yb.reshape(b, L, RWKV_DIM) * g
    u_b = yb.astype(x.dtype) @ lp['w_branch_b']

    gates = jax.nn.sigmoid(gates_raw.astype(f32))
    ga, gb = jnp.split(gates, 2, axis=-1)
    m = (ga * u_a.astype(f32) + gb * u_b.astype(f32)).astype(x.dtype)
    x = x + m @ lp['w_out']

    h2 = _rmsnorm(x, lp['norm2_g'])
    up = h2 @ lp['ffn_w_up']
    ug, uv = jnp.split(up, 2, axis=-1)
    ug, new_ffn = _causal_dwconv(ug, ffn_buf, lp['ffn_conv_w'], lp['ffn_conv_b'])
    x = x + (jax.nn.silu(ug) * uv) @ lp['ffn_w_down']
    return x, (new_conv, new_ssm, new_shift, new_wkv, new_ffn)


def setup_inputs(seed: int = 0) -> dict:
    key = jax.random.key(seed)
    ks = iter(jax.random.split(key, 48))
    f32 = jnp.float32

    def nrm(shape, scale):
        return scale * jax.random.normal(next(ks), shape, f32)

    def unif(shape, lo, hi):
        return jax.random.uniform(next(ks), shape, f32, minval=lo, maxval=hi)

    Dp = DEPTH
    dt0 = jnp.exp(unif((Dp, SSM_HEADS), math.log(1e-3), math.log(1e-1)))
    return {
        'x_prompt': nrm((BATCH, SEQ, D_MODEL), 1.0),
        'x_sample': nrm((DEC_BATCH, DEC_SEQ, D_MODEL), 1.0),
        'state_ssm_conv': nrm((Dp, DEC_BATCH, SSM_CONV - 1, SSM_CONV_DIM), 1.0),
        'state_ssm': nrm((Dp, DEC_BATCH, SSM_HEADS, SSM_HEAD_DIM, SSM_STATE), 0.1),
        'state_rwkv_shift': nrm((Dp, DEC_BATCH, RWKV_SHIFT_DIM), 1.0),
        'state_rwkv': nrm((Dp, DEC_BATCH, RWKV_HEADS, RWKV_HEAD_DIM, RWKV_HEAD_DIM), 0.1),
        'state_ffn_conv': nrm((Dp, DEC_BATCH, FFN_CONV - 1, D_FF), 1.0),
        'norm1_g': 1.0 + nrm((Dp, D_MODEL), 0.02),
        'w_in': nrm((Dp, D_MODEL, IN_DIM), D_MODEL ** -0.5),
        'ssm_conv_w': nrm((Dp, SSM_CONV, SSM_CONV_DIM), SSM_CONV ** -0.5),
        'ssm_conv_b': nrm((Dp, SSM_CONV_DIM), 0.02),
        'ssm_dt_bias': dt0 + jnp.log(-jnp.expm1(-dt0)),
        'ssm_a_log': jnp.log(unif((Dp, SSM_HEADS), 1.0, 16.0)),
        'ssm_d': 1.0 + nrm((Dp, SSM_HEADS), 0.1),
        'ssm_norm_g': 1.0 + nrm((Dp, SSM_D_INNER), 0.02),
        'w_branch_a': nrm((Dp, SSM_D_INNER, D_MODEL), SSM_D_INNER ** -0.5),
        'rwkv_mu': unif((Dp, RWKV_SHIFT_DIM), 0.0, 1.0),
        'rwkv_w0': -0.6 + nrm((Dp, RWKV_DIM), 0.3),
        'rwkv_w_up': nrm((Dp, W_LORA, RWKV_DIM), 0.1 * W_LORA ** -0.5),
        'rwkv_a0': nrm((Dp, RWKV_DIM), 0.1),
        'rwkv_a_up': nrm((Dp, A_LORA, RWKV_DIM), 0.1 * A_LORA ** -0.5),
        'rwkv_g_up': nrm((Dp, G_LORA, RWKV_DIM), G_LORA ** -0.5),
        'rwkv_k_k': 0.85 + nrm((Dp, RWKV_DIM), 0.02),
        'rwkv_k_a': 1.0 + nrm((Dp, RWKV_DIM), 0.02),
        'rwkv_r_k': nrm((Dp, RWKV_HEADS, RWKV_HEAD_DIM), 0.1),
        'rwkv_ln_w': 1.0 + nrm((Dp, RWKV_DIM), 0.02),
        'rwkv_ln_b': nrm((Dp, RWKV_DIM), 0.02),
        'w_branch_b': nrm((Dp, RWKV_DIM, D_MODEL), RWKV_DIM ** -0.5),
        'w_out': nrm((Dp, D_MODEL, D_MODEL), D_MODEL ** -0.5),
        'norm2_g': 1.0 + nrm((Dp, D_MODEL), 0.02),
        'ffn_w_up': nrm((Dp, D_MODEL, 2 * D_FF), D_MODEL ** -0.5),
        'ffn_conv_w': nrm((Dp, FFN_CONV, D_FF), FFN_CONV ** -0.5),
        'ffn_conv_b': nrm((Dp, D_FF), 0.02),
        'ffn_w_down': nrm((Dp, D_FF, D_MODEL), D_FF ** -0.5),
        'final_g': 1.0 + nrm((D_MODEL,), 0.02),
    }


def reference(x_prompt, x_sample, state_ssm_conv, state_ssm, state_rwkv_shift, state_rwkv,
              state_ffn_conv, norm1_g, w_in, ssm_conv_w, ssm_conv_b, ssm_dt_bias, ssm_a_log,
              ssm_d, ssm_norm_g, w_branch_a, rwkv_mu, rwkv_w0, rwkv_w_up, rwkv_a0, rwkv_a_up,
              rwkv_g_up, rwkv_k_k, rwkv_k_a, rwkv_r_k, rwkv_ln_w, rwkv_ln_b, w_branch_b, w_out,
              norm2_g, ffn_w_up, ffn_conv_w, ffn_conv_b, ffn_w_down, final_g):
    xp, xs = x_prompt, x_sample
    bp = xp.shape[0]
    new_p = ([], [], [], [], [])
    new_s = ([], [], [], [], [])
    for i in range(DEPTH):
        lp = {
            'norm1_g': norm1_g[i], 'w_in': w_in[i], 'ssm_conv_w': ssm_conv_w[i],
            'ssm_conv_b': ssm_conv_b[i], 'ssm_dt_bias': ssm_dt_bias[i], 'ssm_a_log': ssm_a_log[i],
            'ssm_d': ssm_d[i], 'ssm_norm_g': ssm_norm_g[i], 'w_branch_a': w_branch_a[i],
            'rwkv_mu': rwkv_mu[i], 'rwkv_w0': rwkv_w0[i], 'rwkv_w_up': rwkv_w_up[i],
            'rwkv_a0': rwkv_a0[i], 'rwkv_a_up': rwkv_a_up[i], 'rwkv_g_up': rwkv_g_up[i],
            'rwkv_k_k': rwkv_k_k[i], 'rwkv_k_a': rwkv_k_a[i], 'rwkv_r_k': rwkv_r_k[i],
            'rwkv_ln_w': rwkv_ln_w[i], 'rwkv_ln_b': rwkv_ln_b[i], 'w_branch_b': w_branch_b[i],
            'w_out': w_out[i], 'norm2_g': norm2_g[i], 'ffn_w_up': ffn_w_up[i],
            'ffn_conv_w': ffn_conv_w[i], 'ffn_conv_b': ffn_conv_b[i], 'ffn_w_down': ffn_w_down[i],
        }
        xp, sp = _layer(
            xp,
            jnp.zeros((bp, SSM_CONV - 1, SSM_CONV_DIM), xp.dtype),
            jnp.zeros((bp, SSM_HEADS, SSM_HEAD_DIM, SSM_STATE), jnp.float32),
            jnp.zeros((bp, RWKV_SHIFT_DIM), xp.dtype),
            jnp.zeros((bp, RWKV_HEADS, RWKV_HEAD_DIM, RWKV_HEAD_DIM), jnp.float32),
            jnp.zeros((bp, FFN_CONV - 1, D_FF), xp.dtype),
            lp)
        xs, ss = _layer(xs, state_ssm_conv[i], state_ssm[i], state_rwkv_shift[i], state_rwkv[i],
                        state_ffn_conv[i], lp)
        for j in range(5):
            new_p[j].append(sp[j])
            new_s[j].append(ss[j])
    y_prompt = _rmsnorm(xp, final_g)
    y_sample = _rmsnorm(xs, final_g)
    return (y_prompt, y_sample,
            jnp.stack(new_p[0]), jnp.stack(new_p[1]), jnp.stack(new_p[2]), jnp.stack(new_p[3]), jnp.stack(new_p[4]),
            jnp.stack(new_s[0]), jnp.stack(new_s[1]), jnp.stack(new_s[2]), jnp.stack(new_s[3]), jnp.stack(new_s[4]))
```

```cpp
#include <hip/hip_runtime.h>
#include <hip/hip_cooperative_groups.h>
#include <cstdio>
#include <cstdint>
namespace cg = cooperative_groups;

#define LAS __attribute__((address_space(3)))
typedef unsigned short bf16_t;
typedef short bf16x8 __attribute__((ext_vector_type(8)));
typedef float f32x4 __attribute__((ext_vector_type(4)));
typedef unsigned u32x4 __attribute__((ext_vector_type(4)));
typedef unsigned u32x2 __attribute__((ext_vector_type(2)));

constexpr int DM = 1024, TP = 16384, TSMP = 1024, T = TP + TSMP, SEQ = 2048, DSEQ = 8, NBP = 8, NBS = 128;
constexpr int DI = 2048, CD = 3072, NH = 32, NS = 128, RSD = 3328, DFF = 2816;
constexpr int N1 = 10752, PW = 10496;
constexpr int PC_Z = 0, PC_XBC = 2048, PC_RW = 5120, PC_GT = 8448, PC_DT = 10496;
constexpr int PC_YB = 2048, PC_BV = 3072;
constexpr float NORM_EPS = 1e-5f, GN_EPS = 64e-5f;
constexpr size_t O_YP = 0, O_YS = (size_t)TP * DM, O_CONVP = O_YS + (size_t)TSMP * DM, O_SSMP = O_CONVP + (size_t)NBP * 3 * CD,
    O_SHIFTP = O_SSMP + (size_t)NBP * NH * 64 * NS, O_RWKVP = O_SHIFTP + (size_t)NBP * RSD, O_FFNP = O_RWKVP + (size_t)NBP * 16 * 64 * 64,
    O_CONVS = O_FFNP + (size_t)NBP * 2 * DFF, O_SSMS = O_CONVS + (size_t)NBS * 3 * CD, O_SHIFTS = O_SSMS + (size_t)NBS * NH * 64 * NS,
    O_RWKVS = O_SHIFTS + (size_t)NBS * RSD, O_FFNS = O_RWKVS + (size_t)NBS * 16 * 64 * 64, O_END = O_FFNS + (size_t)NBS * 2 * DFF;
constexpr size_t MiB = 1u << 20, U34 = 34 * MiB;
constexpr size_t WS_SSA = 0, WS_SS2 = WS_SSA + (size_t)T * 16, WS_SS3 = WS_SS2 + (size_t)T * 4, WS_RSTD1 = WS_SS3 + (size_t)T * 4;
constexpr size_t WS_BAR = 512 * 1024;
constexpr size_t WS_WIN = 1 * MiB, WS_WA = 22 * MiB, WS_WB = 26 * MiB, WS_WOUT = 28 * MiB, WS_WUP = 30 * MiB, WS_WDN = 41 * MiB, WS_WLO = 46 * MiB + 512 * 1024;
constexpr size_t WS_XB = 48 * MiB, WS_LOE = WS_XB, WS_PROJ = 82 * MiB, WS_DT = 431 * MiB, WS_LA = 434 * MiB, WS_LOA = 443 * MiB, WS_LOG = 477 * MiB;
constexpr size_t WS_XC = WS_LOA, WS_BC = WS_XB, WS_RWS = WS_LA;
constexpr size_t WS_MA = WS_LOA, WS_M = WS_LOG, WS_X1 = 82 * MiB, WS_X1B = 150 * MiB, WS_UP = 184 * MiB, WS_ACT = 371 * MiB, WS_END = 511 * MiB;
static_assert(WS_RSTD1 + (size_t)T * 4 <= WS_WIN && WS_PROJ + (size_t)T * PW * 2 <= WS_DT && WS_UP + (size_t)T * 5632 * 2 <= WS_ACT && WS_ACT + (size_t)T * DFF * 2 <= WS_END, "ws map");
constexpr int LDS_BYTES = 135168;
constexpr int NPHASE = 14;

__device__ __forceinline__ float bf2f(bf16_t u) { return __builtin_bit_cast(float, (unsigned)u << 16); }
__device__ __forceinline__ unsigned f2bf(float f) { unsigned u = __builtin_bit_cast(unsigned, f); return (u + 0x7fffu + ((u >> 16) & 1u)) >> 16; }
__device__ __forceinline__ unsigned pk2(float lo, float hi) { unsigned r; asm("v_cvt_pk_bf16_f32 %0, %1, %2" : "=v"(r) : "v"(lo), "v"(hi)); return r; }
__device__ __forceinline__ float lo16(unsigned w) { return __builtin_bit_cast(float, w << 16); }
__device__ __forceinline__ float hi16(unsigned w) { return __builtin_bit_cast(float, w & 0xffff0000u); }
__device__ __forceinline__ float sigmoidf_(float x) { return 1.f / (1.f + __expf(-x)); }
__device__ __forceinline__ float siluf_(float x) { return x / (1.f + __expf(-x)); }
__device__ __forceinline__ float softplusf_(float x) { return x > 20.f ? x : __logf(1.f + __expf(x)); }
__device__ __forceinline__ void rowinfo(int row, int& samp, int& b, int& t) {
    if (row < TP) { samp = 0; b = row >> 11; t = row & 2047; } else { const int r = row - TP; samp = 1; b = r >> 3; t = r & 7; }
}
__device__ __forceinline__ void lds_barrier() { asm volatile("s_waitcnt lgkmcnt(0)\n\ts_barrier" ::: "memory"); }
template <int CTRL> __device__ __forceinline__ float dppf(float v) { return __builtin_bit_cast(float, __builtin_amdgcn_update_dpp(0, __builtin_bit_cast(int, v), CTRL, 0xF, 0xF, true)); }
__device__ __forceinline__ float wave_sum(float v) {
    v += dppf<0xB1>(v); v += dppf<0x4E>(v); v += dppf<0x141>(v); v += dppf<0x140>(v);
    const int iv = __builtin_bit_cast(int, v);
    return (__builtin_bit_cast(float, __builtin_amdgcn_readlane(iv, 0)) + __builtin_bit_cast(float, __builtin_amdgcn_readlane(iv, 16))) +
           (__builtin_bit_cast(float, __builtin_amdgcn_readlane(iv, 32)) + __builtin_bit_cast(float, __builtin_amdgcn_readlane(iv, 48)));
}
__device__ __forceinline__ float sum8(float v) { v += dppf<0xB1>(v); v += dppf<0x4E>(v); v += dppf<0x141>(v); return v; }

struct Args { const float* in[35]; float* out; unsigned char* ws; int ph_lo, ph_hi, rep, pad; };
struct Ctx {
    unsigned char* ws; float* out; const unsigned* tab;
    __device__ __forceinline__ const float* in(int i) const {
        const unsigned lo = __builtin_amdgcn_readfirstlane(tab[2 * i]), hi = __builtin_amdgcn_readfirstlane(tab[2 * i + 1]);
        return (const float*)(((unsigned long long)hi << 32) | lo);
    }
};

namespace pg8 {
constexpr int BM = 256, BK = 64, HALF = 128, HTB = HALF * BK * 2, NXCD = 8, WGM = 8;
__host__ __device__ __forceinline__ int lds_byte(int r, int c) { const int st = (r >> 4) * 2 + (c >> 5), rr = r & 15, cc = c & 31, ob = rr * 64 + cc * 2; return st * 1024 + (ob ^ (((ob >> 9) & 1) << 5)); }
__host__ __device__ __forceinline__ void stage_rc(int b, int& R, int& C) { const int st = b / 1024, sb = b % 1024, swz = sb ^ (((sb >> 9) & 1) << 5); R = (st >> 1) * 16 + swz / 64; C = (st & 1) * 32 + (swz % 64) / 2; }
__host__ __device__ __forceinline__ int perm32(int rho) { const int n = rho >> 4, i = rho & 15; return 8 * (i >> 2) + 4 * n + (i & 3); }
struct Unit { int pm, pn; };
struct Gemm { const bf16_t* A; const bf16_t* Bt; int lda, M, N, K; };
struct StaticOrder {
    int nM, nN, nwg, G, c;
    __device__ void init(int M, int N, int G_, int c_) { nM = M / BM; nN = N / BM; nwg = nM * nN; G = G_; c = c_; }
    __device__ bool next(int i, Unit& u) const {
        const long L = (long)i * G + c; if (L >= nwg) return false;
        int wgid = (int)L; { const int q = nwg / NXCD, r = nwg % NXCD, xcd = wgid % NXCD, off = wgid / NXCD; wgid = (xcd < r ? xcd * (q + 1) : r * (q + 1) + (xcd - r) * q) + off; }
        const int nig = WGM * nN, gid = wgid / nig, fm = gid * WGM, gsz = (nM - fm) < WGM ? (nM - fm) : WGM;
        u.pm = fm + ((wgid % nig) % gsz); u.pn = (wgid % nig) / gsz; return true;
    }
};

template <class Epi, class Sched>
__device__ __forceinline__ void gemm_phase(LAS unsigned char* lds, const Gemm g, const Sched& S, const Epi& E) {
    const int tid = threadIdx.x, wid = __builtin_amdgcn_readfirstlane(tid >> 6), lane = tid & 63, wr = wid >> 2, wc = wid & 3, fr = lane & 15, fq = lane >> 4;
    const int K = g.K, nt = K / BK;
    unsigned voffA[2], voffB[2];
#pragma unroll
    for (int i = 0; i < 2; ++i) { int R, C; stage_rc(tid * 16 + i * 8192, R, C); const int Rb = (R & ~31) + perm32(R & 31);
        voffA[i] = (unsigned)(R * g.lda + C) * 2u; voffB[i] = (unsigned)(Rb * K + C) * 2u; }
    const size_t kstep = (size_t)(BK * 2);
    const size_t hstepA = (size_t)HALF * g.lda * 2, hstepB = (size_t)HALF * K * 2;
    const size_t tstepA = 2 * hstepA, tstepB = 2 * hstepB;
    const unsigned ldsw = (unsigned)wid * 1024u;
    const int aoff = lds_byte(wr * 64 + fr, fq * 8), boff = lds_byte(wc * 32 + fr, fq * 8);
#define PG8_SA(b, h) (((b) * 2 + (h)) * HTB)
#define PG8_SB(b, h) ((4 + (b) * 2 + (h)) * HTB)
#define PG8_STAGE(bufoff, gbase, voff) do { _Pragma("unroll") for (int _i = 0; _i < 2; ++_i) \
        __builtin_amdgcn_global_load_lds((const unsigned*)((const char*)(gbase) + (voff)[_i]), (LAS unsigned*)(lds + (bufoff) + ldsw + _i * 8192), 16, 0, 0); } while (0)
#define PG8_LDA(dst, b, h) do { _Pragma("unroll") for (int m = 0; m < 4; ++m) _Pragma("unroll") for (int k = 0; k < 2; ++k) dst[m][k] = *(const LAS bf16x8*)(lds + PG8_SA(b, h) + aoff + m * 2048 + k * 1024); } while (0)
#define PG8_LDB(dst, b, h) do { _Pragma("unroll") for (int n = 0; n < 2; ++n) _Pragma("unroll") for (int k = 0; k < 2; ++k) dst[n][k] = *(const LAS bf16x8*)(lds + PG8_SB(b, h) + boff + n * 2048 + k * 1024); } while (0)
#define PG8_MMA(ai, bj, At, Bt) do { __builtin_amdgcn_s_setprio(1); _Pragma("unroll") for (int m = 0; m < 4; ++m) _Pragma("unroll") for (int n = 0; n < 2; ++n) _Pragma("unroll") for (int k = 0; k < 2; ++k) \
        acc[ai][bj][m][n] = __builtin_amdgcn_mfma_f32_16x16x32_bf16(Bt[n][k], At[m][k], acc[ai][bj][m][n], 0, 0, 0); __builtin_amdgcn_s_setprio(0); } while (0)
#define PG8_WAIT_V(n) asm volatile("s_waitcnt vmcnt(" #n ")" ::: "memory")
#define PG8_WAIT_L(n) asm volatile("s_waitcnt lgkmcnt(" #n ")" ::: "memory")
#define PG8_BAR __builtin_amdgcn_s_barrier()
#define PG8_SCHED __builtin_amdgcn_sched_barrier(0)
    Unit cur, nxt; int ui = 0;
    if (!S.next(0, cur)) return;
    f32x4 acc[2][2][4][2];
#pragma unroll
    for (int a = 0; a < 2; ++a)
#pragma unroll
        for (int b = 0; b < 2; ++b)
#pragma unroll
            for (int m = 0; m < 4; ++m)
#pragma unroll
                for (int n = 0; n < 2; ++n) acc[a][b][m][n] = (f32x4){0.f, 0.f, 0.f, 0.f};
    bf16x8 At[4][2], B0[2][2], B1[2][2];
    const char* cA = (const char*)g.A + (size_t)cur.pm * tstepA; const char* cB = (const char*)g.Bt + (size_t)cur.pn * tstepB;
    PG8_STAGE(PG8_SB(0, 0), cB, voffB); PG8_STAGE(PG8_SB(0, 1), cB + hstepB, voffB); PG8_STAGE(PG8_SA(0, 0), cA, voffA); PG8_STAGE(PG8_SA(0, 1), cA + hstepA, voffA);
    if (wr == 1) PG8_BAR;
    PG8_WAIT_V(2); PG8_BAR;
    PG8_STAGE(PG8_SB(1, 0), cB + kstep, voffB); PG8_STAGE(PG8_SA(1, 0), cA + kstep, voffA); PG8_STAGE(PG8_SB(1, 1), cB + hstepB + kstep, voffB);
    PG8_WAIT_V(6); PG8_BAR;
    for (;;) {
        const bool has_next = S.next(ui + 1, nxt);
        const char* nA = has_next ? (const char*)g.A + (size_t)nxt.pm * tstepA : cA; const char* nB = has_next ? (const char*)g.Bt + (size_t)nxt.pn * tstepB : cB;
#pragma unroll 1
        for (int t = 0; t < nt; t += 2) {
            const bool last = (t == nt - 2);
            const char* a1 = cA + (size_t)(t + 1) * kstep;
            const char* a2 = last ? nA : cA + (size_t)(t + 2) * kstep; const char* b2 = last ? nB : cB + (size_t)(t + 2) * kstep;
            const char* a3 = a2 + kstep; const char* b3 = b2 + kstep;
            PG8_LDB(B0, 0, 0); PG8_LDB(B1, 0, 1); PG8_SCHED; PG8_LDA(At, 0, 0); PG8_STAGE(PG8_SA(1, 1), a1 + hstepA, voffA);
            PG8_WAIT_V(8); PG8_WAIT_L(0); PG8_BAR; PG8_MMA(0, 0, At, B0); PG8_MMA(0, 1, At, B1); PG8_BAR; PG8_SCHED;
            PG8_LDA(At, 0, 1); PG8_STAGE(PG8_SB(0, 0), b2, voffB); PG8_STAGE(PG8_SB(0, 1), b2 + hstepB, voffB); PG8_STAGE(PG8_SA(0, 0), a2, voffA);
            PG8_WAIT_V(8); PG8_WAIT_L(0); PG8_BAR; PG8_MMA(1, 0, At, B0); PG8_MMA(1, 1, At, B1); PG8_BAR; PG8_SCHED;
            PG8_LDB(B0, 1, 0); PG8_LDB(B1, 1, 1); PG8_SCHED; PG8_LDA(At, 1, 0); PG8_STAGE(PG8_SA(0, 1), a2 + hstepA, voffA);
            PG8_WAIT_V(8); PG8_WAIT_L(0); PG8_BAR; PG8_MMA(0, 0, At, B0); PG8_MMA(0, 1, At, B1); PG8_BAR; PG8_SCHED;
            PG8_LDA(At, 1, 1); PG8_STAGE(PG8_SB(1, 0), b3, voffB); PG8_STAGE(PG8_SB(1, 1), b3 + hstepB, voffB); PG8_STAGE(PG8_SA(1, 0), a3, voffA);
            PG8_WAIT_V(8); PG8_WAIT_L(0); PG8_BAR; PG8_MMA(1, 0, At, B0); PG8_MMA(1, 1, At, B1); PG8_BAR; PG8_SCHED;
        }
        if (wr == 0) PG8_BAR;
        E(acc, cur, wr, wc, fr, fq);
        if (!has_next) break;
#pragma unroll
        for (int a = 0; a < 2; ++a)
#pragma unroll
            for (int b = 0; b < 2; ++b)
#pragma unroll
                for (int m = 0; m < 4; ++m)
#pragma unroll
                    for (int n = 0; n < 2; ++n) acc[a][b][m][n] = (f32x4){0.f, 0.f, 0.f, 0.f};
        cur = nxt; cA = nA; cB = nB; ++ui;
        if (wr == 1) PG8_BAR;
    }
    PG8_WAIT_V(0);
    PG8_BAR;
#undef PG8_SA
#undef PG8_SB
#undef PG8_STAGE
#undef PG8_LDA
#undef PG8_LDB
#undef PG8_MMA
#undef PG8_WAIT_V
#undef PG8_WAIT_L
#undef PG8_BAR
#undef PG8_SCHED
}
}

__device__ __forceinline__ void st8bf(bf16_t* p, f32x4 a, f32x4 b) { u32x4 w; w.x = pk2(a[0], a[1]); w.y = pk2(a[2], a[3]); w.z = pk2(b[0], b[1]); w.w = pk2(b[2], b[3]); *(u32x4*)p = w; }

template <int SEG> __device__ __forceinline__ void epi1_seg(const f32x4 (&acc)[2][2][4][2], const pg8::Unit& u, int wr, int wc, int fr, int fq, unsigned char* ws, float* out, const float* dtb) {
    const int rbase = u.pm * 256 + wr * 64 + fr, cbase = u.pn * 256 + wc * 32 + 8 * fq;
    bf16_t* PROJ = (bf16_t*)(ws + WS_PROJ);
#pragma unroll
    for (int ai = 0; ai < 2; ++ai)
#pragma unroll
        for (int m = 0; m < 4; ++m) {
            const int row = rbase + ai * 128 + m * 16;
            int samp, b, t; rowinfo(row, samp, b, t);
            const int L = samp ? DSEQ : SEQ;
            const float rs = ((const float*)(ws + WS_RSTD1))[row];
#pragma unroll
            for (int bj = 0; bj < 2; ++bj) {
                const int col = cbase + bj * 128;
                f32x4 v0 = acc[ai][bj][m][0] * rs, v1 = acc[ai][bj][m][1] * rs;
                if (SEG == 0) {
#pragma unroll
                    for (int i = 0; i < 4; ++i) { v0[i] = siluf_(v0[i]); v1[i] = siluf_(v1[i]); }
                    st8bf(PROJ + (size_t)row * PW + col, v0, v1);
                } else if (SEG == 1) {
                    st8bf(PROJ + (size_t)row * PW + col, v0, v1);
                    if (t >= L - 3) { float* o = out + (samp ? O_CONVS : O_CONVP) + (size_t)(b * 3 + (t - (L - 3))) * CD + (col - PC_XBC); *(f32x4*)o = v0; *(f32x4*)(o + 4) = v1; }
                } else if (SEG == 2) {
                    st8bf(PROJ + (size_t)row * PW + col, v0, v1);
                    if (t == L - 1) { float* o = out + (samp ? O_SHIFTS : O_SHIFTP) + (size_t)b * RSD + (col - PC_RW); *(f32x4*)o = v0; *(f32x4*)(o + 4) = v1; }
                } else if (SEG == 3) {
#pragma unroll
                    for (int i = 0; i < 4; ++i) { v0[i] = sigmoidf_(v0[i]); v1[i] = sigmoidf_(v1[i]); }
                    st8bf(PROJ + (size_t)row * PW + col, v0, v1);
                } else {
                    if (col < PC_DT + 32) {
                        const int c = col - PC_DT; float* d = (float*)(ws + WS_DT) + (size_t)row * 32 + c;
                        const f32x4 b0 = *(const f32x4*)(dtb + c), b1 = *(const f32x4*)(dtb + c + 4);
                        f32x4 o0, o1;
#pragma unroll
                        for (int i = 0; i < 4; ++i) { o0[i] = softplusf_(v0[i] + b0[i]); o1[i] = softplusf_(v1[i] + b1[i]); }
                        *(f32x4*)d = o0; *(f32x4*)(d + 4) = o1;
                    }
                }
            }
        }
}

template <int SEG> __device__ __forceinline__ void epi2_seg(const f32x4 (&acc)[2][2][4][2], const pg8::Unit& u, int wr, int wc, int fr, int fq, unsigned char* ws, const float* bias) {
    const int rbase = u.pm * 256 + wr * 64 + fr, cbase = (u.pn & 3) * 256 + wc * 32 + 8 * fq;
    bf16_t* O = (bf16_t*)(ws + (SEG == 0 ? WS_LOE : SEG == 1 ? WS_LOA : WS_LOG));
#pragma unroll
    for (int bj = 0; bj < 2; ++bj) {
        const int c = cbase + bj * 128;
        f32x4 b0 = {0.f, 0.f, 0.f, 0.f}, b1 = {0.f, 0.f, 0.f, 0.f};
        if (SEG < 2) { b0 = *(const f32x4*)(bias + c); b1 = *(const f32x4*)(bias + c + 4); }
#pragma unroll
        for (int ai = 0; ai < 2; ++ai)
#pragma unroll
            for (int m = 0; m < 4; ++m) {
                const int row = rbase + ai * 128 + m * 16;
                f32x4 v0 = acc[ai][bj][m][0], v1 = acc[ai][bj][m][1];
                if (SEG == 0) {
#pragma unroll
                    for (int i = 0; i < 4; ++i) { v0[i] = sigmoidf_(v0[i] + b0[i]) * 0.6065306597f; v1[i] = sigmoidf_(v1[i] + b1[i]) * 0.6065306597f; }
                } else if (SEG == 1) {
#pragma unroll
                    for (int i = 0; i < 4; ++i) { v0[i] = sigmoidf_(v0[i] + b0[i]); v1[i] = sigmoidf_(v1[i] + b1[i]); }
                }
                st8bf(O + (size_t)row * 1024 + c, v0, v1);
            }
    }
}
template <int MODE> struct Epi {
    static constexpr int mode = MODE; unsigned char* ws; float* out; const float* p0; const float* p1; int dry;
    __device__ __forceinline__ void operator()(const f32x4 (&acc)[2][2][4][2], const pg8::Unit& u, int wr, int wc, int fr, int fq) const {
        if (mode == 1) {
            if (u.pn < 8) epi1_seg<0>(acc, u, wr, wc, fr, fq, ws, out, p0); else if (u.pn < 20) epi1_seg<1>(acc, u, wr, wc, fr, fq, ws, out, p0);
            else if (u.pn < 33) epi1_seg<2>(acc, u, wr, wc, fr, fq, ws, out, p0); else if (u.pn < 41) epi1_seg<3>(acc, u, wr, wc, fr, fq, ws, out, p0);
            else epi1_seg<4>(acc, u, wr, wc, fr, fq, ws, out, p0);
            return;
        }
        if (mode == 2) {
            if (u.pn < 4) epi2_seg<0>(acc, u, wr, wc, fr, fq, ws, p0); else if (u.pn < 8) epi2_seg<1>(acc, u, wr, wc, fr, fq, ws, p1); else epi2_seg<2>(acc, u, wr, wc, fr, fq, ws, p0);
            return;
        }
        const int rbase = u.pm * 256 + wr * 64 + fr, cbase = u.pn * 256 + wc * 32 + 8 * fq;
        bf16_t* PROJ = (bf16_t*)(ws + WS_PROJ);
#pragma unroll
        for (int ai = 0; ai < 2; ++ai)
#pragma unroll
            for (int m = 0; m < 4; ++m) {
                const int row = rbase + ai * 128 + m * 16;
                int samp, b, t; rowinfo(row, samp, b, t);
                const int L = samp ? DSEQ : SEQ;
                float rs = 1.f;
                if (mode == 1) rs = ((const float*)(ws + WS_RSTD1))[row];
                else if (mode == 6) rs = rsqrtf(((const float*)(ws + WS_SS2))[row] * (1.f / DM) + NORM_EPS);
                float ssq = 0.f;
#pragma unroll
                for (int bj = 0; bj < 2; ++bj) {
                    const int col = cbase + bj * 128;
                    f32x4 v0 = acc[ai][bj][m][0] * rs, v1 = acc[ai][bj][m][1] * rs;
                    if (mode == 3 || mode == 4) {
                        const u32x4 gw = *(const u32x4*)(PROJ + (size_t)row * PW + PC_GT + (mode == 4 ? 1024 : 0) + col);
                        f32x4 g0 = {lo16(gw.x), hi16(gw.x), lo16(gw.y), hi16(gw.y)}, g1 = {lo16(gw.z), hi16(gw.z), lo16(gw.w), hi16(gw.w)};
                        v0 = v0 * g0; v1 = v1 * g1;
                        if (mode == 3) st8bf((bf16_t*)(ws + WS_MA) + (size_t)row * 1024 + col, v0, v1);
                        else {
                            const u32x4 mw = *(const u32x4*)((const bf16_t*)(ws + WS_MA) + (size_t)row * 1024 + col);
                            f32x4 m0 = {lo16(mw.x), hi16(mw.x), lo16(mw.y), hi16(mw.y)}, m1 = {lo16(mw.z), hi16(mw.z), lo16(mw.w), hi16(mw.w)};
                            st8bf((bf16_t*)(ws + WS_M) + (size_t)row * 1024 + col, v0 + m0, v1 + m1);
                        }
                    } else if (mode == 5) {
                        const float* xr = (row < TP ? p0 + (size_t)row * DM : p1 + (size_t)(row - TP) * DM) + col;
                        v0 = v0 + *(const f32x4*)xr; v1 = v1 + *(const f32x4*)(xr + 4);
                        float* x1 = (float*)(ws + WS_X1) + (size_t)row * DM + col; *(f32x4*)x1 = v0; *(f32x4*)(x1 + 4) = v1;
                        st8bf((bf16_t*)(ws + WS_X1B) + (size_t)row * DM + col, v0, v1);
#pragma unroll
                        for (int i = 0; i < 4; ++i) ssq += v0[i] * v0[i] + v1[i] * v1[i];
                    } else if (mode == 6) {
                        st8bf((bf16_t*)(ws + WS_UP) + (size_t)row * 5632 + col, v0, v1);
                        if (col < DFF && t >= L - 2) { float* o = out + (samp ? O_FFNS : O_FFNP) + (size_t)(b * 2 + (t - (L - 2))) * DFF + col; *(f32x4*)o = v0; *(f32x4*)(o + 4) = v1; }
                    } else {
                        const float* x1 = (const float*)(ws + WS_X1) + (size_t)row * DM + col;
                        v0 = v0 + *(const f32x4*)x1; v1 = v1 + *(const f32x4*)(x1 + 4);
                        float* o = out + (size_t)row * DM + col; *(f32x4*)o = v0; *(f32x4*)(o + 4) = v1;
#pragma unroll
                        for (int i = 0; i < 4; ++i) ssq += v0[i] * v0[i] + v1[i] * v1[i];
                    }
                }
                if (mode == 5 || mode == 7) {
                    ssq += __shfl_xor(ssq, 16); ssq += __shfl_xor(ssq, 32);
                    if (fq == 0) atomicAdd((float*)(ws + (mode == 5 ? WS_SS2 : WS_SS3)) + row, dry ? 0.f : ssq);
                }
            }
    }
};

struct TrItem { const float* W; int N, k0, n0; bf16_t* WT; int ldk, drow, dk; const float* kscale; };
constexpr int TR_EARLY = 16 * 329 + 32 * 32 + 16 * 32 + 32 + 32 + 64, TR_ALL = TR_EARLY + 16 * 32 + 16 * 176 + 44 * 32;
__device__ __forceinline__ TrItem tr_item(const Ctx& a, int it) {
    constexpr int I_IN = 16 * 329, I_A = 32 * 32, I_B = 16 * 32, I_O = 16 * 32, I_UP = 16 * 176, I_LW = 32, I_LA = 32, I_LG = 64;
    unsigned char* ws = a.ws; int r = it;
    if (r < I_IN) { const int kb = r / 329, nb = r % 329, n0 = 32 * nb; const int d = n0 < 5120 ? n0 : (n0 < 5152 ? PC_DT + (n0 - 5120) : n0 - 32);
        return TrItem{a.in(8), 10528, 64 * kb, n0, (bf16_t*)(ws + WS_WIN), 1024, d, 64 * kb, a.in(7)}; } r -= I_IN;
    if (r < I_A) return TrItem{a.in(15), 1024, 64 * (r / 32), 32 * (r % 32), (bf16_t*)(ws + WS_WA), 2048, 32 * (r % 32), 64 * (r / 32), nullptr}; r -= I_A;
    if (r < I_B) return TrItem{a.in(27), 1024, 64 * (r / 32), 32 * (r % 32), (bf16_t*)(ws + WS_WB), 1024, 32 * (r % 32), 64 * (r / 32), nullptr}; r -= I_B;
    if (r < I_LW) return TrItem{a.in(18), 1024, 0, 32 * r, (bf16_t*)(ws + WS_WLO), 256, 32 * r, 0, nullptr}; r -= I_LW;
    if (r < I_LA) return TrItem{a.in(20), 1024, 0, 32 * r, (bf16_t*)(ws + WS_WLO), 256, 1024 + 32 * r, 64, nullptr}; r -= I_LA;
    if (r < I_LG) return TrItem{a.in(21), 1024, 64 * (r / 32), 32 * (r % 32), (bf16_t*)(ws + WS_WLO), 256, 2048 + 32 * (r % 32), 128 + 64 * (r / 32), nullptr}; r -= I_LG;
    if (r < I_O) return TrItem{a.in(28), 1024, 64 * (r / 32), 32 * (r % 32), (bf16_t*)(ws + WS_WOUT), 1024, 32 * (r % 32), 64 * (r / 32), nullptr}; r -= I_O;
    if (r < I_UP) return TrItem{a.in(30), 5632, 64 * (r / 176), 32 * (r % 176), (bf16_t*)(ws + WS_WUP), 1024, 32 * (r % 176), 64 * (r / 176), a.in(29)}; r -= I_UP;
    return TrItem{a.in(33), 1024, 64 * (r / 32), 32 * (r % 32), (bf16_t*)(ws + WS_WDN), 2816, 32 * (r % 32), 64 * (r / 32), nullptr};
}
__device__ __forceinline__ void tr_load(const TrItem& d, float (&v)[32], float (&sc)[32], int lane) {
#pragma unroll
    for (int i = 0; i < 32; ++i) { const int kk = 2 * i + (lane >> 5); v[i] = d.W[(size_t)(d.k0 + kk) * d.N + d.n0 + (lane & 31)]; sc[i] = d.kscale ? d.kscale[d.k0 + kk] : 1.f; }
}
__device__ __forceinline__ void tr_store(const TrItem& d, const float (&v)[32], const float (&sc)[32], float* scr, int lane) {
#pragma unroll
    for (int i = 0; i < 32; ++i) { const int kk = 2 * i + (lane >> 5); scr[kk * 33 + (lane & 31)] = v[i] * sc[i]; }
    asm volatile("s_waitcnt lgkmcnt(0)" ::: "memory");
    const int c = lane & 7;
#pragma unroll
    for (int j = 0; j < 4; ++j) { const int n = (lane >> 3) + 8 * j; const float* s = scr + (8 * c) * 33 + n;
        u32x4 o; o.x = pk2(s[0 * 33], s[1 * 33]); o.y = pk2(s[2 * 33], s[3 * 33]); o.z = pk2(s[4 * 33], s[5 * 33]); o.w = pk2(s[6 * 33], s[7 * 33]);
        *(u32x4*)(d.WT + (size_t)(d.drow + n) * d.ldk + d.dk + 8 * c) = o; }
    asm volatile("s_waitcnt lgkmcnt(0)" ::: "memory");
}
__device__ __forceinline__ void tr_run(const Ctx& a, unsigned char* lds, int first, int NIT, int w0, int NGW) {
    const int lane = threadIdx.x & 63, wave = threadIdx.x >> 6;
    float* scr = (float*)(lds + wave * 16384);
    {
        float vA[32], sA[32], vB[32], sB[32];
        int it = first + w0;
        if (it < NIT) { const TrItem d = tr_item(a, it); tr_load(d, vA, sA, lane); }
        while (it < NIT) {
            int it2 = it + NGW;
            if (it2 < NIT) { const TrItem d = tr_item(a, it2); tr_load(d, vB, sB, lane); }
            { const TrItem d = tr_item(a, it); tr_store(d, vA, sA, scr, lane); }
            it = it2; if (it >= NIT) break;
            it2 = it + NGW;
            if (it2 < NIT) { const TrItem d = tr_item(a, it2); tr_load(d, vA, sA, lane); }
            { const TrItem d = tr_item(a, it); tr_store(d, vB, sB, scr, lane); }
            it = it2;
        }
    }
}
__device__ __forceinline__ void phase0(const Ctx& a, unsigned char* lds) {
    const int tid = threadIdx.x, lane = tid & 63, wave = tid >> 6;
    const int gw = blockIdx.x * 8 + wave, NGW = gridDim.x * 8;
    unsigned char* ws = a.ws;
    tr_run(a, lds, 0, TR_EARLY, gw, NGW);
    const int gt = blockIdx.x * 512 + tid, NGT = gridDim.x * 512;
    const u32x4 z4 = {0u, 0u, 0u, 0u};
    for (int i = gt; i < 224 * 128; i += NGT) *(u32x4*)(ws + WS_WIN + (size_t)10528 * 2048 + (size_t)i * 16) = z4;
    for (int i = gt; i < 3072 * 32; i += NGT) { const int row = i >> 5, c8 = (i & 31) * 8, seg = row >> 10;
        const bool nz = (seg == 0) ? (c8 < 64) : (seg == 1) ? (c8 >= 64 && c8 < 128) : (c8 >= 128);
        if (!nz) *(u32x4*)(ws + WS_WLO + ((size_t)row * 256 + c8) * 2) = z4; }
    for (int i = gt; i < T * 6; i += NGT) ((float*)(ws + WS_SSA))[i] = 0.f;
    for (int r0 = gw; r0 < T; r0 += 2 * NGW) {
        f32x4 v[2][4];
#pragma unroll
        for (int k = 0; k < 2; ++k) { const int row = r0 + k * NGW; if (row < T) {
            const float* xr = row < TP ? a.in(0) + (size_t)row * DM : a.in(1) + (size_t)(row - TP) * DM;
#pragma unroll
            for (int j = 0; j < 4; ++j) v[k][j] = ((const f32x4*)xr)[lane + 64 * j]; } }
#pragma unroll
        for (int k = 0; k < 2; ++k) { const int row = r0 + k * NGW; if (row < T) {
            float s = 0.f;
#pragma unroll
            for (int j = 0; j < 4; ++j) s += v[k][j][0] * v[k][j][0] + v[k][j][1] * v[k][j][1] + v[k][j][2] * v[k][j][2] + v[k][j][3] * v[k][j][3];
            s = wave_sum(s);
            if (lane == 0) ((float*)(ws + WS_RSTD1))[row] = rsqrtf(s * (1.f / DM) + NORM_EPS);
            u32x2* o = (u32x2*)(ws + WS_XB + (size_t)row * DM * 2);
#pragma unroll
            for (int j = 0; j < 4; ++j) { u32x2 w; w.x = pk2(v[k][j][0], v[k][j][1]); w.y = pk2(v[k][j][2], v[k][j][3]); o[lane + 64 * j] = w; } } }
    }
}

__device__ __forceinline__ void dt_phase(const Ctx& a) {
    const int lane = threadIdx.x & 63, fr = lane & 15, fq = lane >> 4, gw = blockIdx.x * 8 + (threadIdx.x >> 6), NGW = gridDim.x * 8;
    const bf16_t* XB = (const bf16_t*)(a.ws + WS_XB); const bf16_t* WIN = (const bf16_t*)(a.ws + WS_WIN);
    const float* rstd = (const float*)(a.ws + WS_RSTD1); const float* bias = a.in(11); float* DT = (float*)(a.ws + WS_DT);
    for (int rb = gw; rb < T / 16; rb += NGW) {
        const bf16_t* ap = XB + (size_t)(16 * rb + fr) * DM + 8 * fq; const bf16_t* bp = WIN + (size_t)(PC_DT + fr) * DM + 8 * fq;
        f32x4 acc0 = {0.f, 0.f, 0.f, 0.f}, acc1 = acc0;
#pragma unroll 1
        for (int k0 = 0; k0 < 32; k0 += 16) {
            bf16x8 av[16], b0[16], b1[16];
#pragma unroll
            for (int kk = 0; kk < 16; ++kk) { av[kk] = *(const bf16x8*)(ap + 32 * (k0 + kk)); b0[kk] = *(const bf16x8*)(bp + 32 * (k0 + kk)); b1[kk] = *(const bf16x8*)(bp + (size_t)16 * DM + 32 * (k0 + kk)); }
#pragma unroll
            for (int kk = 0; kk < 16; ++kk) { acc0 = __builtin_amdgcn_mfma_f32_16x16x32_bf16(av[kk], b0[kk], acc0, 0, 0, 0); acc1 = __builtin_amdgcn_mfma_f32_16x16x32_bf16(av[kk], b1[kk], acc1, 0, 0, 0); }
        }
        const float bc0 = bias[fr], bc1 = bias[16 + fr];
#pragma unroll
        for (int r = 0; r < 4; ++r) { const int row = 16 * rb + 4 * fq + r; const float rs = rstd[row];
            DT[(size_t)row * 32 + fr] = softplusf_(rs * acc0[r] + bc0); DT[(size_t)row * 32 + 16 + fr] = softplusf_(rs * acc1[r] + bc1); }
    }
}
__device__ __forceinline__ void unpack8(const u32x4 w, float (&f)[8]) { f[0] = lo16(w.x); f[1] = hi16(w.x); f[2] = lo16(w.y); f[3] = hi16(w.y); f[4] = lo16(w.z); f[5] = hi16(w.z); f[6] = lo16(w.w); f[7] = hi16(w.w); }
__device__ __forceinline__ u32x4 pack8(const float (&f)[8]) { u32x4 w; w.x = pk2(f[0], f[1]); w.y = pk2(f[2], f[3]); w.z = pk2(f[4], f[5]); w.w = pk2(f[6], f[7]); return w; }
__device__ __forceinline__ void lora_prep(const Ctx& a) {
    const bf16_t* PROJ = (const bf16_t*)(a.ws + WS_PROJ); bf16_t* LA = (bf16_t*)(a.ws + WS_LA);
    const float* mu = a.in(16); const float* sh = a.in(4);
    for (int i = blockIdx.x * 512 + threadIdx.x; i < T * 32; i += gridDim.x * 512) {
        const int row = i >> 5, j = (i & 31) * 8, c = 3072 + j;
        int samp, b, t; rowinfo(row, samp, b, t);
        float raw[8], prev[8], o[8];
        unpack8(*(const u32x4*)(PROJ + (size_t)row * PW + PC_RW + c), raw);
        if (t > 0) unpack8(*(const u32x4*)(PROJ + (size_t)(row - 1) * PW + PC_RW + c), prev);
        else {
#pragma unroll
            for (int k = 0; k < 8; ++k) prev[k] = samp ? sh[(size_t)b * RSD + c + k] : 0.f; }
#pragma unroll
        for (int k = 0; k < 8; ++k) { const float mx = raw[k] + (prev[k] - raw[k]) * mu[c + k]; o[k] = j < 64 ? tanhf(mx) : (j < 128 ? mx : sigmoidf_(mx)); }
        *(u32x4*)(LA + (size_t)row * 256 + j) = pack8(o);
    }
}

__device__ __forceinline__ void conv_load(u32x4 (&u)[11], const bf16_t* PROJ, int o, int cd) {
    const int row0 = 8 * o; const bool samp = row0 >= TP; const int t0 = samp ? 0 : (row0 & 2047);
    const bf16_t* src = PROJ + (size_t)row0 * PW + PC_XBC + cd;
#pragma unroll
    for (int i = 0; i < 3; ++i) { u[i] = (u32x4){0u, 0u, 0u, 0u}; if (t0 > 0) u[i] = *(const u32x4*)(src + (long)(i - 3) * PW); }
#pragma unroll
    for (int i = 3; i < 11; ++i) u[i] = *(const u32x4*)(src + (long)(i - 3) * PW);
}
__device__ __forceinline__ void conv_compute(const u32x4 (&u)[11], int o, int cd, const float (&w)[4][8], const float (&bb)[8], const float* cst, bf16_t* XC, bf16_t* BC) {
    const int row0 = 8 * o; const bool samp = row0 >= TP; const int b = (row0 - TP) >> 3;
    float x[11][8];
#pragma unroll
    for (int i = 0; i < 11; ++i) unpack8(u[i], x[i]);
    if (samp) {
#pragma unroll
        for (int i = 0; i < 3; ++i) { const f32x4 p0 = *(const f32x4*)(cst + (size_t)(b * 3 + i) * CD + cd), p1 = *(const f32x4*)(cst + (size_t)(b * 3 + i) * CD + cd + 4);
#pragma unroll
            for (int j = 0; j < 4; ++j) { x[i][j] = p0[j]; x[i][4 + j] = p1[j]; } }
    }
    bf16_t* dst = cd < 2048 ? XC + (size_t)row0 * 2048 + cd : BC + (size_t)row0 * 1024 + (cd - 2048);
    const int dld = cd < 2048 ? 2048 : 1024;
#pragma unroll
    for (int l = 0; l < 8; ++l) { float o8[8];
#pragma unroll
        for (int j = 0; j < 8; ++j) o8[j] = siluf_(bb[j] + w[0][j] * x[l][j] + w[1][j] * x[l + 1][j] + w[2][j] * x[l + 2][j] + w[3][j] * x[l + 3][j]);
        *(u32x4*)(dst + (size_t)l * dld) = pack8(o8); }
}
__device__ __forceinline__ void conv_prepass(const Ctx& a) {
    const bf16_t* PROJ = (const bf16_t*)(a.ws + WS_PROJ); bf16_t* XC = (bf16_t*)(a.ws + WS_XC); bf16_t* BC = (bf16_t*)(a.ws + WS_BC);
    const float* cw = a.in(9); const float* cbias = a.in(10); const float* cst = a.in(2);
    const int gt = blockIdx.x * 512 + threadIdx.x, NGT = gridDim.x * 512, NCOL = 384, nslab = NGT / NCOL;
    if (gt >= nslab * NCOL) return;
    const int cd = (gt % NCOL) * 8, NO = T / 8;
    float w[4][8], bb[8];
#pragma unroll
    for (int j = 0; j < 4; ++j) { const f32x4 p0 = *(const f32x4*)(cw + j * CD + cd), p1 = *(const f32x4*)(cw + j * CD + cd + 4);
#pragma unroll
        for (int k = 0; k < 4; ++k) { w[j][k] = p0[k]; w[j][4 + k] = p1[k]; } }
    { const f32x4 p0 = *(const f32x4*)(cbias + cd), p1 = *(const f32x4*)(cbias + cd + 4);
#pragma unroll
      for (int k = 0; k < 4; ++k) { bb[k] = p0[k]; bb[4 + k] = p1[k]; } }
    u32x4 uA[11], uB[11];
    int o = gt / NCOL;
    if (o < NO) conv_load(uA, PROJ, o, cd);
    while (o < NO) {
        int o2 = o + nslab;
        if (o2 < NO) conv_load(uB, PROJ, o2, cd);
        conv_compute(uA, o, cd, w, bb, cst, XC, BC);
        o = o2; if (o >= NO) break;
        o2 = o + nslab;
        if (o2 < NO) conv_load(uA, PROJ, o2, cd);
        conv_compute(uB, o, cd, w, bb, cst, XC, BC);
        o = o2;
    }
}

__device__ __forceinline__ void ssd_prompt_unit(const Ctx& a, int b, int head, unsigned char* lds, bool dry) {
    const int tid = threadIdx.x, lane = tid & 63, wave = tid >> 6, fr = lane & 15, fq = lane >> 4, g = head >> 3;
    bf16_t* Cs = (bf16_t*)lds;
    bf16_t* Bs = (bf16_t*)(lds + 17408);
    bf16_t* Hs = (bf16_t*)(lds + 34816);
    bf16_t* BwT = (bf16_t*)(lds + 52224);
    bf16_t* XT = (bf16_t*)(lds + 70656);
    bf16_t* Ps = (bf16_t*)(lds + 79872);
    bf16_t* Zs = (bf16_t*)(lds + 89088);
    bf16_t* Ys = (bf16_t*)(lds + 98304);
    float* csf = (float*)(lds + 107520); float* dtf = (float*)(lds + 107776);
    bf16_t* PROJ = (bf16_t*)(a.ws + WS_PROJ); const bf16_t* XC = (const bf16_t*)(a.ws + WS_XC); const bf16_t* BC = (const bf16_t*)(a.ws + WS_BC);
    const float* DT = (const float*)(a.ws + WS_DT); float* SSA = (float*)(a.ws + WS_SSA);
    const float Aneg = -__expf(a.in(12)[head]), Dh = a.in(13)[head];
    const int ll = tid >> 3, c8 = tid & 7, lb2 = tid >> 4, c16 = tid & 15;
    f32x4 hacc[4];
#pragma unroll
    for (int i = 0; i < 4; ++i) hacc[i] = (f32x4){0.f, 0.f, 0.f, 0.f};
    for (int i = tid; i < 64 * 136 / 2; i += 512) ((unsigned*)Hs)[i] = 0u;
    u32x4 rx, rz, rb0, rb1, rc0, rc1; float rdt = 0.f;
#define SSD_LOAD(c) do { const size_t r0_ = (size_t)b * SEQ + (size_t)(c) * 64; \
        rx = *(const u32x4*)(XC + (r0_ + ll) * 2048 + head * 64 + 8 * c8); rz = *(const u32x4*)(PROJ + (r0_ + ll) * PW + PC_Z + head * 64 + 8 * c8); \
        rb0 = *(const u32x4*)(BC + (r0_ + lb2) * 1024 + g * 128 + 8 * c16); rb1 = *(const u32x4*)(BC + (r0_ + 32 + lb2) * 1024 + g * 128 + 8 * c16); \
        rc0 = *(const u32x4*)(BC + (r0_ + lb2) * 1024 + 512 + g * 128 + 8 * c16); rc1 = *(const u32x4*)(BC + (r0_ + 32 + lb2) * 1024 + 512 + g * 128 + 8 * c16); \
        if (wave == 0) rdt = DT[(r0_ + lane) * 32 + head]; } while (0)
    SSD_LOAD(0);
    for (int c = 0; c < 32; ++c) {
        const int row0 = b * SEQ + c * 64;
        if (wave == 0) { float cs = rdt * Aneg;
#pragma unroll
            for (int o = 1; o < 64; o <<= 1) { const float v = __shfl_up(cs, o); if (lane >= o) cs += v; }
            csf[lane] = cs; dtf[lane] = rdt; }
        { const unsigned xw[4] = {rx.x, rx.y, rx.z, rx.w};
#pragma unroll
          for (int j = 0; j < 4; ++j) { XT[(8 * c8 + 2 * j) * 72 + ll] = (bf16_t)(xw[j] & 0xffffu); XT[(8 * c8 + 2 * j + 1) * 72 + ll] = (bf16_t)(xw[j] >> 16); } }
        *(u32x4*)(Zs + ll * 72 + 8 * c8) = rz;
        *(u32x4*)(Bs + lb2 * 136 + 8 * c16) = rb0; *(u32x4*)(Bs + (32 + lb2) * 136 + 8 * c16) = rb1;
        *(u32x4*)(Cs + lb2 * 136 + 8 * c16) = rc0; *(u32x4*)(Cs + (32 + lb2) * 136 + 8 * c16) = rc1;
        lds_barrier();
        if (c + 1 < 32) SSD_LOAD(c + 1);
        const float cs_last = csf[63];
        {
            const int n = tid & 127, lq = tid >> 7;
            float v[16];
#pragma unroll
            for (int i = 0; i < 16; ++i) { const int l = 16 * lq + i; v[i] = bf2f(Bs[l * 136 + n]) * dtf[l] * __expf(cs_last - csf[l]); }
            u32x4 w; w.x = pk2(v[0], v[1]); w.y = pk2(v[2], v[3]); w.z = pk2(v[4], v[5]); w.w = pk2(v[6], v[7]);
            *(u32x4*)(BwT + n * 72 + 16 * lq) = w;
            w.x = pk2(v[8], v[9]); w.y = pk2(v[10], v[11]); w.z = pk2(v[12], v[13]); w.w = pk2(v[14], v[15]);
            *(u32x4*)(BwT + n * 72 + 16 * lq + 8) = w;
        }
        {
            const int lb = wave >> 1;
#pragma unroll
            for (int j = 0; j < 2; ++j) {
                const int sb = 2 * (wave & 1) + j;
                f32x4 acc = {0.f, 0.f, 0.f, 0.f};
                if (sb <= lb) {
#pragma unroll
                    for (int kk = 0; kk < 4; ++kk) {
                        const bf16x8 av = *(const bf16x8*)(Cs + (16 * lb + fr) * 136 + 32 * kk + 8 * fq);
                        const bf16x8 bv = *(const bf16x8*)(Bs + (16 * sb + fr) * 136 + 32 * kk + 8 * fq);
                        acc = __builtin_amdgcn_mfma_f32_16x16x32_bf16(av, bv, acc, 0, 0, 0);
                    }
                }
                const int s = 16 * sb + fr; const float css = csf[s], dts = dtf[s];
#pragma unroll
                for (int r = 0; r < 4; ++r) { const int l = 16 * lb + 4 * fq + r;
                    const float p = (s <= l) ? acc[r] * __expf(csf[l] - css) * dts : 0.f;
                    Ps[l * 72 + s] = (bf16_t)f2bf(p); }
            }
        }
        lds_barrier();
        {
            const int lb = wave >> 1;
            float ssq[4] = {0.f, 0.f, 0.f, 0.f};
#pragma unroll
            for (int j = 0; j < 2; ++j) {
                const int pb = 2 * (wave & 1) + j;
                f32x4 yd = {0.f, 0.f, 0.f, 0.f}, yo = {0.f, 0.f, 0.f, 0.f};
#pragma unroll
                for (int kk = 0; kk < 2; ++kk) {
                    const bf16x8 av = *(const bf16x8*)(Ps + (16 * lb + fr) * 72 + 32 * kk + 8 * fq);
                    const bf16x8 bv = *(const bf16x8*)(XT + (16 * pb + fr) * 72 + 32 * kk + 8 * fq);
                    yd = __builtin_amdgcn_mfma_f32_16x16x32_bf16(av, bv, yd, 0, 0, 0);
                }
                if (c > 0) {
#pragma unroll
                    for (int kk = 0; kk < 4; ++kk) {
                        const bf16x8 av = *(const bf16x8*)(Cs + (16 * lb + fr) * 136 + 32 * kk + 8 * fq);
                        const bf16x8 bv = *(const bf16x8*)(Hs + (16 * pb + fr) * 136 + 32 * kk + 8 * fq);
                        yo = __builtin_amdgcn_mfma_f32_16x16x32_bf16(av, bv, yo, 0, 0, 0);
                    }
                }
                const int p = 16 * pb + fr;
#pragma unroll
                for (int r = 0; r < 4; ++r) { const int l = 16 * lb + 4 * fq + r;
                    const float x = bf2f(XT[p * 72 + l]);
                    const float y = yd[r] + yo[r] * __expf(csf[l]) + Dh * x;
                    const bf16_t zo = Zs[l * 72 + p]; const float yz = y * bf2f(zo);
                    Ys[l * 72 + p] = dry ? zo : (bf16_t)f2bf(yz); ssq[r] += yz * yz; }
            }
#pragma unroll
            for (int r = 0; r < 4; ++r) { float s = ssq[r]; s += dppf<0xB1>(s); s += dppf<0x4E>(s); s += dppf<0x141>(s); s += dppf<0x140>(s);
                if (fr == 0) atomicAdd(SSA + (size_t)(row0 + 16 * lb + 4 * fq + r) * 4 + g, dry ? 0.f : s); }
        }
        {
            const float dec = __expf(cs_last);
#pragma unroll
            for (int pb = 0; pb < 4; ++pb) {
                hacc[pb] = hacc[pb] * dec;
#pragma unroll
                for (int kk = 0; kk < 2; ++kk) {
                    const bf16x8 av = *(const bf16x8*)(XT + (16 * pb + fr) * 72 + 32 * kk + 8 * fq);
                    const bf16x8 bv = *(const bf16x8*)(BwT + (16 * wave + fr) * 72 + 32 * kk + 8 * fq);
                    hacc[pb] = __builtin_amdgcn_mfma_f32_16x16x32_bf16(av, bv, hacc[pb], 0, 0, 0);
                }
            }
        }
        lds_barrier();
#pragma unroll
        for (int pb = 0; pb < 4; ++pb)
#pragma unroll
            for (int r = 0; r < 4; ++r) Hs[(16 * pb + 4 * fq + r) * 136 + 16 * wave + fr] = (bf16_t)f2bf(hacc[pb][r]);
        *(u32x4*)(PROJ + (size_t)(row0 + ll) * PW + PC_Z + head * 64 + 8 * c8) = *(const u32x4*)(Ys + ll * 72 + 8 * c8);
    }
#undef SSD_LOAD
    float* so = a.out + O_SSMP + (size_t)(b * NH + head) * 64 * NS;
#pragma unroll
    for (int pb = 0; pb < 4; ++pb)
#pragma unroll
        for (int r = 0; r < 4; ++r) so[(16 * pb + 4 * fq + r) * NS + 16 * wave + fr] = hacc[pb][r];
    __syncthreads();
}

__device__ __forceinline__ void ssd_sample_unit(const Ctx& a, int b, int g, unsigned char* lds, bool dry) {
    const int tid = threadIdx.x;
    float* xs = (float*)lds;
    float* Bsm = (float*)(lds + 16384);
    float* Csm = (float*)(lds + 20480);
    float* dts = (float*)(lds + 24576);
    float* css = (float*)(lds + 24832);
    float* cbs = (float*)(lds + 25088);
    float* ssq = (float*)(lds + 25344);
    bf16_t* PROJ = (bf16_t*)(a.ws + WS_PROJ); const bf16_t* XC = (const bf16_t*)(a.ws + WS_XC); const bf16_t* BC = (const bf16_t*)(a.ws + WS_BC);
    const float* DT = (const float*)(a.ws + WS_DT);
    const int row0 = TP + b * 8;
    const int p = tid >> 3, nq = tid & 7;
    const float* hbase = a.in(3) + ((size_t)(b * NH + g * 8) * 64 + p) * NS + 16 * nq;
    f32x4 hq[4];
#pragma unroll
    for (int j = 0; j < 4; ++j) hq[j] = ((const f32x4*)hbase)[j];
#pragma unroll
    for (int l = 0; l < 8; ++l) xs[l * 512 + tid] = bf2f(XC[(size_t)(row0 + l) * 2048 + g * 512 + tid]);
    if (tid < 256) { const int which = tid >> 7, n = tid & 127; float* dst = which ? Csm : Bsm;
#pragma unroll
        for (int l = 0; l < 8; ++l) dst[l * 128 + n] = bf2f(BC[(size_t)(row0 + l) * 1024 + which * 512 + g * 128 + n]); }
    if (tid < 64) dts[tid] = DT[(size_t)(row0 + (tid >> 3)) * 32 + g * 8 + (tid & 7)];
    if (tid < 8) ssq[tid] = 0.f;
    __syncthreads();
    if (tid < 8) { const float An = -__expf(a.in(12)[g * 8 + tid]); float c = 0.f;
#pragma unroll
        for (int l = 0; l < 8; ++l) { c += dts[l * 8 + tid] * An; css[l * 8 + tid] = c; } }
    { const int pr = tid >> 3, l = pr >> 3, s = pr & 7; float d = 0.f;
#pragma unroll
        for (int j = 0; j < 16; ++j) d += Csm[l * 128 + 16 * nq + j] * Bsm[s * 128 + 16 * nq + j];
        d = sum8(d); if (nq == 0) cbs[l * 8 + s] = d; }
    __syncthreads();
    for (int hh = 0; hh < 8; ++hh) {
        const int head = g * 8 + hh;
        float h0[16];
#pragma unroll
        for (int j = 0; j < 4; ++j) { h0[4 * j] = hq[j][0]; h0[4 * j + 1] = hq[j][1]; h0[4 * j + 2] = hq[j][2]; h0[4 * j + 3] = hq[j][3]; }
        if (hh + 1 < 8) {
#pragma unroll
            for (int j = 0; j < 4; ++j) hq[j] = ((const f32x4*)(hbase + (size_t)(hh + 1) * 64 * NS))[j];
        }
        float csl[8], xl[8], dl[8];
#pragma unroll
        for (int l = 0; l < 8; ++l) { csl[l] = css[l * 8 + hh]; xl[l] = xs[l * 512 + hh * 64 + p]; dl[l] = dts[l * 8 + hh]; }
        float yoff[8];
#pragma unroll
        for (int l = 0; l < 8; ++l) { float s = 0.f;
#pragma unroll
            for (int j = 0; j < 16; ++j) s += Csm[l * 128 + 16 * nq + j] * h0[j];
            yoff[l] = sum8(s); }
        const float dec = __expf(csl[7]);
        float hn[16];
#pragma unroll
        for (int j = 0; j < 16; ++j) hn[j] = h0[j] * dec;
#pragma unroll
        for (int l = 0; l < 8; ++l) { const float w = xl[l] * dl[l] * __expf(csl[7] - csl[l]);
#pragma unroll
            for (int j = 0; j < 16; ++j) hn[j] += Bsm[l * 128 + 16 * nq + j] * w; }
        float* ho = a.out + O_SSMS + ((size_t)(b * NH + head) * 64 + p) * NS + 16 * nq;
#pragma unroll
        for (int j = 0; j < 4; ++j) ((f32x4*)ho)[j] = (f32x4){hn[4 * j], hn[4 * j + 1], hn[4 * j + 2], hn[4 * j + 3]};
        float yo = 0.f, cl = 0.f, xme = 0.f;
#pragma unroll
        for (int l = 0; l < 8; ++l) { if (nq == l) { yo = yoff[l]; cl = csl[l]; xme = xl[l]; } }
        float y = yo * __expf(cl) + a.in(13)[head] * xme;
#pragma unroll
        for (int s = 0; s < 8; ++s) { if (s <= nq) y += cbs[nq * 8 + s] * __expf(cl - csl[s]) * dl[s] * xl[s]; }
        bf16_t* zp = PROJ + (size_t)(row0 + nq) * PW + PC_Z + head * 64 + p;
        const bf16_t zo = *zp; const float yz = y * bf2f(zo);
        *zp = dry ? zo : (bf16_t)f2bf(yz);
        atomicAdd(ssq + nq, yz * yz);
    }
    __syncthreads();
    if (tid < 8) atomicAdd((float*)(a.ws + WS_SSA) + (size_t)(row0 + tid) * 4 + g, dry ? 0.f : ssq[tid]);
    __syncthreads();
}

__device__ __forceinline__ void ya_norm(const Ctx& a, bool dry, int gt0, int NGT) {
    bf16_t* PROJ = (bf16_t*)(a.ws + WS_PROJ); const float* SSA = (const float*)(a.ws + WS_SSA); const float* ng = a.in(14);
    for (int i0 = gt0; i0 < T * 256; i0 += 4 * NGT) {
        u32x4 w[4]; float rs[4];
#pragma unroll
        for (int k = 0; k < 4; ++k) { const int i = i0 + k * NGT; if (i < T * 256) { const int row = i >> 8, c = (i & 255) * 8;
            w[k] = *(const u32x4*)(PROJ + (size_t)row * PW + c); rs[k] = SSA[(size_t)row * 4 + (c >> 9)]; } }
#pragma unroll
        for (int k = 0; k < 4; ++k) { const int i = i0 + k * NGT; if (i < T * 256) { const int row = i >> 8, c = (i & 255) * 8;
            const float r = rsqrtf(rs[k] * (1.f / 512.f) + NORM_EPS);
            float f[8]; unpack8(w[k], f);
            const f32x4 g0 = *(const f32x4*)(ng + c), g1 = *(const f32x4*)(ng + c + 4);
#pragma unroll
            for (int j = 0; j < 4; ++j) { f[j] *= r * g0[j]; f[4 + j] *= r * g1[j]; }
            *(u32x4*)(PROJ + (size_t)row * PW + c) = dry ? w[k] : pack8(f); } }
    }
}

constexpr int RW_TB = 32, RW_STEPF = 388;
typedef float f32x2 __attribute__((ext_vector_type(2)));
struct RwConst { float mu_r, mu_k, mu_v, kk_w, ka_w, rk_w; };
__device__ __forceinline__ void rwkv_scalars(const Ctx& a) {
    bf16_t* PROJ = (bf16_t*)(a.ws + WS_PROJ); const bf16_t* LOA = (const bf16_t*)(a.ws + WS_LOA); float* RWS = (float*)(a.ws + WS_RWS);
    const int lane = threadIdx.x & 63, gw = blockIdx.x * 8 + (threadIdx.x >> 6), NGW = gridDim.x * 8;
    const float* sh = a.in(4);
    for (int item = gw; item < 2048; item += NGW) {
        const int half = item & 1, rbeg = (item >> 1) * 17, c0 = half * 512 + lane * 8, head = half * 8 + (lane >> 3);
        float mur[8], muk[8], muv[8], kkw[8], kaw[8], rkw[8];
#pragma unroll
        for (int j = 0; j < 2; ++j) {
            const f32x4 t0 = *(const f32x4*)(a.in(16) + c0 + 4 * j), t1 = *(const f32x4*)(a.in(16) + 1024 + c0 + 4 * j), t2 = *(const f32x4*)(a.in(16) + 2048 + c0 + 4 * j);
            const f32x4 t3 = *(const f32x4*)(a.in(22) + c0 + 4 * j), t4 = *(const f32x4*)(a.in(23) + c0 + 4 * j), t5 = *(const f32x4*)(a.in(24) + c0 + 4 * j);
#pragma unroll
            for (int k = 0; k < 4; ++k) { mur[4 * j + k] = t0[k]; muk[4 * j + k] = t1[k]; muv[4 * j + k] = t2[k]; kkw[4 * j + k] = t3[k]; kaw[4 * j + k] = t4[k]; rkw[4 * j + k] = t5[k]; }
        }
        const bf16_t* pr = PROJ + (size_t)rbeg * PW + PC_RW + c0;
        u32x4 pR = {0u, 0u, 0u, 0u}, pK = pR, pV = pR;
        if (rbeg > 0) { pR = *(const u32x4*)(pr - (long)PW); pK = *(const u32x4*)(pr + 1024 - (long)PW); pV = *(const u32x4*)(pr + 2048 - (long)PW); }
        u32x4 cR = *(const u32x4*)pr, cK = *(const u32x4*)(pr + 1024), cV = *(const u32x4*)(pr + 2048), cA = *(const u32x4*)(LOA + (size_t)rbeg * 1024 + c0);
        for (int i = 0; i < 17; ++i) {
            const int row = rbeg + i;
            u32x4 nR = cR, nK = cK, nV = cV, nA = cA;
            if (i + 1 < 17) { const bf16_t* pn = pr + (size_t)(i + 1) * PW; nR = *(const u32x4*)pn; nK = *(const u32x4*)(pn + 1024); nV = *(const u32x4*)(pn + 2048); nA = *(const u32x4*)(LOA + (size_t)(row + 1) * 1024 + c0); }
            int samp, b, t; rowinfo(row, samp, b, t);
            float rr[8], rk[8], rv[8], qr[8], qk[8], qv[8], av[8], vx[8];
            unpack8(cR, rr); unpack8(cK, rk); unpack8(cV, rv); unpack8(cA, av);
            if (t > 0) { unpack8(pR, qr); unpack8(pK, qk); unpack8(pV, qv); }
            else {
#pragma unroll
                for (int j = 0; j < 8; ++j) { const int c = c0 + j; qr[j] = samp ? sh[(size_t)b * RSD + c] : 0.f; qk[j] = samp ? sh[(size_t)b * RSD + 1024 + c] : 0.f; qv[j] = samp ? sh[(size_t)b * RSD + 2048 + c] : 0.f; } }
            float n2 = 0.f, brs = 0.f, krs = 0.f, bon = 0.f;
#pragma unroll
            for (int j = 0; j < 8; ++j) {
                const float r = rr[j] + (qr[j] - rr[j]) * mur[j], kx = rk[j] + (qk[j] - rk[j]) * muk[j]; vx[j] = rv[j] + (qv[j] - rv[j]) * muv[j];
                const float kkr = kx * kkw[j], kp = kx * (1.f + (av[j] - 1.f) * kaw[j]);
                n2 += kkr * kkr; brs += kkr * av[j] * r; krs += kp * r; bon += r * kp * rkw[j]; }
            n2 = sum8(n2); brs = sum8(brs); krs = sum8(krs); bon = sum8(bon);
            const float inv = 1.f / fmaxf(sqrtf(n2), 1e-12f);
            if ((lane & 7) == 0) *(f32x4*)(RWS + ((size_t)row * 16 + head) * 4) = (f32x4){inv, brs * inv, krs, bon};
            float o[8];
#pragma unroll
            for (int j = 0; j < 8; ++j) o[j] = bon * vx[j];
            *(u32x4*)(PROJ + (size_t)row * PW + PC_BV + c0) = pack8(o);
            pR = cR; pK = cK; pV = cV; cR = nR; cK = nK; cV = nV; cA = nA;
        }
    }
}
template <int NS, int NPRE> struct RwPrep { float rr[NS], rk[NS], rv[NS], le[NS], la[NS], lp[NPRE]; f32x4 sc[NS]; float q0r, q0k, q0v; int npre; };
template <int NS, int NPRE>
__device__ __forceinline__ void rwkv_prep_load(RwPrep<NS, NPRE>& P, const bf16_t* PROJ, const bf16_t* LOE, const bf16_t* LOA, const float* RWS, int row0, int tblock, int tfirst, int h, int lane, const float* shiftprev) {
    const int cr = h * 64 + lane;
    {
        const bf16_t* pr = PROJ + (size_t)(row0 + tfirst) * PW + PC_RW + cr;
        if (tfirst > 0) { P.q0r = bf2f(pr[-(long)PW]); P.q0k = bf2f(pr[1024 - (long)PW]); P.q0v = bf2f(pr[2048 - (long)PW]); }
        else if (shiftprev) { P.q0r = shiftprev[cr]; P.q0k = shiftprev[1024 + cr]; P.q0v = shiftprev[2048 + cr]; }
        else { P.q0r = 0.f; P.q0k = 0.f; P.q0v = 0.f; }
    }
    P.npre = tfirst - tblock;
#pragma unroll
    for (int j = 0; j < NPRE; ++j) { const int jj = j < P.npre ? j : 0; P.lp[j] = bf2f(LOE[(size_t)(row0 + tblock + jj) * 1024 + cr]); }
#pragma unroll
    for (int i = 0; i < NS; ++i) {
        const size_t row = (size_t)(row0 + tfirst + i);
        const bf16_t* pr = PROJ + row * PW + PC_RW + cr;
        P.rr[i] = bf2f(pr[0]); P.rk[i] = bf2f(pr[1024]); P.rv[i] = bf2f(pr[2048]);
        P.le[i] = bf2f(LOE[row * 1024 + cr]); P.la[i] = bf2f(LOA[row * 1024 + cr]);
        P.sc[i] = *(const f32x4*)(RWS + (row * 16 + h) * 4);
    }
}
template <int NS, int NPRE>
__device__ __forceinline__ void rwkv_prep_compute(const RwPrep<NS, NPRE>& P, float* slot0, int lane, const RwConst& K) {
    float esum = 0.f;
#pragma unroll
    for (int j = 0; j < NPRE; ++j) esum += (j < P.npre) ? P.lp[j] : 0.f;
    float Wprev = __expf(-esum);
#pragma unroll
    for (int i = 0; i < NS; ++i) {
        const float qr = i ? P.rr[i ? i - 1 : 0] : P.q0r, qk = i ? P.rk[i ? i - 1 : 0] : P.q0k, qv = i ? P.rv[i ? i - 1 : 0] : P.q0v;
        const float r = P.rr[i] + (qr - P.rr[i]) * K.mu_r, kx = P.rk[i] + (qk - P.rk[i]) * K.mu_k, vx = P.rv[i] + (qv - P.rv[i]) * K.mu_v;
        const float Wt = Wprev * __expf(-P.le[i]), inv = 1.f / Wt, av = P.la[i];
        const float kk = kx * K.kk_w * P.sc[i][0];
        const float kp = kx * (1.f + (av - 1.f) * K.ka_w), bb = kk * av;
        float* d = slot0 + (size_t)i * RW_STEPF;
        d[lane] = -kk * Wprev; d[64 + lane] = Wt * r; d[128 + lane] = Wt; d[192 + lane] = bb * inv; d[256 + lane] = kp * inv; d[320 + lane] = vx;
        if (lane == 0) { d[384] = P.sc[i][1]; d[385] = P.sc[i][2]; }
        Wprev = Wt;
    }
}
struct RwStep { f32x4 n, r, b, k; f32x2 vv, sc; };
__device__ __forceinline__ void rw_load(RwStep& R, const float* d, int q, int v0) {
    R.n = *(const f32x4*)(d + 4 * q); R.r = *(const f32x4*)(d + 64 + 4 * q);
    R.b = *(const f32x4*)(d + 192 + 4 * q); R.k = *(const f32x4*)(d + 256 + 4 * q);
    R.vv = *(const f32x2*)(d + 320 + v0); R.sc = *(const f32x2*)(d + 384);
}
#define LOH(x) __builtin_shufflevector(x, x, 0, 1)
#define HIH(x) __builtin_shufflevector(x, x, 2, 3)
__device__ __forceinline__ float sum16(float v) { v += dppf<0xB1>(v); v += dppf<0x4E>(v); v += dppf<0x141>(v); v += dppf<0x140>(v); return v; }
template <int VAR = 0> __device__ __forceinline__ void rw_step(f32x2 (&s)[2][2], const RwStep& c, int q, bf16_t* yo) {
    f32x2 a0 = s[0][0] * LOH(c.n), a1 = s[1][0] * LOH(c.n), e0 = s[0][0] * LOH(c.r), e1 = s[1][0] * LOH(c.r);
    a0 = s[0][1] * HIH(c.n) + a0; a1 = s[1][1] * HIH(c.n) + a1; e0 = s[0][1] * HIH(c.r) + e0; e1 = s[1][1] * HIH(c.r) + e1;
    float sa0 = a0.x + a0.y, sa1 = a1.x + a1.y, y20 = e0.x + e0.y, y21 = e1.x + e1.y;
    if (VAR != 1) { sa0 = sum16(sa0); sa1 = sum16(sa1); y20 = sum16(y20); y21 = sum16(y21); }
    const float y0 = y20 + sa0 * c.sc.x + c.vv.x * c.sc.y, y1 = y21 + sa1 * c.sc.x + c.vv.y * c.sc.y;
    const f32x2 s0v = {sa0, sa0}, s1v = {sa1, sa1}, v0v = {c.vv.x, c.vv.x}, v1v = {c.vv.y, c.vv.y};
    s[0][0] = s0v * LOH(c.b) + (v0v * LOH(c.k) + s[0][0]);
    s[0][1] = s0v * HIH(c.b) + (v0v * HIH(c.k) + s[0][1]);
    s[1][0] = s1v * LOH(c.b) + (v1v * LOH(c.k) + s[1][0]);
    s[1][1] = s1v * HIH(c.b) + (v1v * HIH(c.k) + s[1][1]);
    if (q == 0) *(unsigned*)yo = pk2(y0, y1);
}
template <int VAR = 0> __device__ __forceinline__ void rwkv_scan_block(f32x2 (&s)[2][2], const float* stp, int nb, int q, int v0, bf16_t* yo) {
    RwStep c0, c1; rw_load(c0, stp, q, v0);
    if (VAR == 5) {
        c1 = c0;
        for (int tt = 0; tt < nb; tt += 2) { rw_step<0>(s, c0, q, yo + (size_t)tt * PW); rw_step<0>(s, c1, q, yo + (size_t)(tt + 1) * PW); }
    } else if (VAR == 6) {
        f32x4 accv = {0.f, 0.f, 0.f, 0.f};
        for (int tt = 0; tt < nb; tt += 2) {
            rw_load(c1, stp + (size_t)(tt + 1) * RW_STEPF, q, v0); accv = accv + c0.n + c0.r + c0.b + c0.k;
            rw_load(c0, stp + (size_t)((tt + 2 < nb) ? tt + 2 : tt) * RW_STEPF, q, v0); accv = accv + c1.n + c1.r + c1.b + c1.k;
        }
        s[0][0] = LOH(accv); s[0][1] = HIH(accv);
    } else
    for (int tt = 0; tt < nb; tt += 2) {
        rw_load(c1, stp + (size_t)(tt + 1) * RW_STEPF, q, v0);
        rw_step<VAR>(s, c0, q, yo + (size_t)tt * PW);
        rw_load(c0, stp + (size_t)((tt + 2 < nb) ? tt + 2 : tt) * RW_STEPF, q, v0);
        rw_step<VAR>(s, c1, q, yo + (size_t)(tt + 1) * PW);
    }
    const f32x4 wend = *(const f32x4*)(stp + (size_t)(nb - 1) * RW_STEPF + 128 + 4 * q);
#pragma unroll
    for (int i = 0; i < 2; ++i) { s[i][0] = s[i][0] * LOH(wend); s[i][1] = s[i][1] * HIH(wend); }
}
__device__ __forceinline__ void rw_state_load(f32x2 (&s)[2][2], const float* S0, int v0, int q) {
#pragma unroll
    for (int i = 0; i < 2; ++i) { const f32x4 t = *(const f32x4*)(S0 + (v0 + i) * 64 + 4 * q); s[i][0] = LOH(t); s[i][1] = HIH(t); }
}
__device__ __forceinline__ void rw_state_store(const f32x2 (&s)[2][2], float* So, int v0, int q) {
#pragma unroll
    for (int i = 0; i < 2; ++i) *(f32x4*)(So + (v0 + i) * 64 + 4 * q) = (f32x4){s[i][0].x, s[i][0].y, s[i][1].x, s[i][1].y};
}
__device__ __forceinline__ RwConst rw_consts(const Ctx& a, int cr) {
    RwConst K; K.mu_r = a.in(16)[cr]; K.mu_k = a.in(16)[1024 + cr]; K.mu_v = a.in(16)[2048 + cr]; K.kk_w = a.in(22)[cr]; K.ka_w = a.in(23)[cr]; K.rk_w = a.in(24)[cr]; return K;
}
__device__ __forceinline__ void rwkv_sample_unit(const Ctx& a, int u, unsigned char* lds) {
    const int tid = threadIdx.x, lane = tid & 63, wave = tid >> 6, b = u >> 4, h = u & 15, cr = h * 64 + lane;
    float* stp = (float*)lds; bf16_t* PROJ = (bf16_t*)(a.ws + WS_PROJ);
    const int row0 = TP + b * 8, v = wave * 8 + 2 * (lane >> 4), q = lane & 15;
    f32x2 s[2][2]; rw_state_load(s, a.in(5) + (size_t)u * 4096, v, q);
    const RwConst K = rw_consts(a, cr);
    { RwPrep<1, 7> P; rwkv_prep_load<1, 7>(P, PROJ, (const bf16_t*)(a.ws + WS_LOE), (const bf16_t*)(a.ws + WS_LOA), (const float*)(a.ws + WS_RWS), row0, 0, wave, h, lane, a.in(4) + (size_t)b * RSD);
      rwkv_prep_compute<1, 7>(P, stp + wave * RW_STEPF, lane, K); }
    __syncthreads();
    rwkv_scan_block(s, stp, 8, q, v, PROJ + (size_t)row0 * PW + PC_YB + h * 64 + v);
    rw_state_store(s, a.out + O_RWKVS + (size_t)u * 4096, v, q);
    __syncthreads();
}
struct RwStep1 { f32x4 n, r, w, b, k; float vv; f32x2 sc; };
__device__ __forceinline__ void rw_load1(RwStep1& R, const float* d, int q, int v) {
    R.n = *(const f32x4*)(d + 4 * q); R.r = *(const f32x4*)(d + 64 + 4 * q); R.w = *(const f32x4*)(d + 128 + 4 * q);
    R.b = *(const f32x4*)(d + 192 + 4 * q); R.k = *(const f32x4*)(d + 256 + 4 * q);
    R.vv = d[320 + v]; R.sc = *(const f32x2*)(d + 384);
}
__device__ __forceinline__ void rw_step1(f32x2 (&s)[2], const RwStep1& c, int q, bf16_t* yo) {
    f32x2 a0 = s[0] * LOH(c.n), e0 = s[0] * LOH(c.r);
    a0 = s[1] * HIH(c.n) + a0; e0 = s[1] * HIH(c.r) + e0;
    const float sa = sum16(a0.x + a0.y), y2 = sum16(e0.x + e0.y);
    const float y = y2 + sa * c.sc.x + c.vv * c.sc.y;
    const f32x2 sav = {sa, sa}, vvv = {c.vv, c.vv};
    s[0] = s[0] * LOH(c.w) + (sav * LOH(c.b) + vvv * LOH(c.k));
    s[1] = s[1] * HIH(c.w) + (sav * HIH(c.b) + vvv * HIH(c.k));
    if (q == 0) *yo = (bf16_t)f2bf(y);
}
template <int VAR = 0> __device__ __forceinline__ void rwkv_prompt_unit(const Ctx& a, int u, unsigned char* lds) {
    const int tid = threadIdx.x, lane = tid & 63, wave = tid >> 6, bh = u >> 1, half = u & 1, b = bh >> 4, h = bh & 15, cr = h * 64 + lane;
    float* buf = (float*)lds; bf16_t* PROJ = (bf16_t*)(a.ws + WS_PROJ);
    const bf16_t* LOE = (const bf16_t*)(a.ws + WS_LOE); const bf16_t* LOA = (const bf16_t*)(a.ws + WS_LOA);
    const int row0 = b * SEQ, v = half * 32 + (wave & 3) * 8 + 2 * (lane >> 4), q = lane & 15, pw = wave - 4;
    constexpr int NBLK = SEQ / RW_TB, BUFF = RW_TB * RW_STEPF;
    f32x2 s[2][2] = {{{0.f, 0.f}, {0.f, 0.f}}, {{0.f, 0.f}, {0.f, 0.f}}};
    const RwConst K = rw_consts(a, cr);
    const float* RWS = (const float*)(a.ws + WS_RWS);
    RwPrep<8, 24> P;
    if (wave >= 4) { rwkv_prep_load<8, 24>(P, PROJ, LOE, LOA, RWS, row0, 0, 8 * pw, h, lane, nullptr); rwkv_prep_compute<8, 24>(P, buf + 8 * pw * RW_STEPF, lane, K);
        rwkv_prep_load<8, 24>(P, PROJ, LOE, LOA, RWS, row0, RW_TB, RW_TB + 8 * pw, h, lane, nullptr); }
    else __builtin_amdgcn_s_setprio(2);
    lds_barrier();
    for (int blk = 0; blk < NBLK; ++blk) {
        if (wave < 4) { if (VAR != 2) rwkv_scan_block<VAR>(s, buf + (blk & 1) * BUFF, RW_TB, q, v, PROJ + (size_t)(row0 + blk * RW_TB) * PW + PC_YB + h * 64 + v); }
        else if (blk + 1 < NBLK && VAR != 3) { rwkv_prep_compute<8, 24>(P, buf + ((blk + 1) & 1) * BUFF + 8 * pw * RW_STEPF, lane, K);
            if (blk + 2 < NBLK) rwkv_prep_load<8, 24>(P, PROJ, LOE, LOA, RWS, row0, (blk + 2) * RW_TB, (blk + 2) * RW_TB + 8 * pw, h, lane, nullptr); }
        lds_barrier();
    }
    __builtin_amdgcn_s_setprio(0);
    __syncthreads();
    if (wave < 4) rw_state_store(s, a.out + O_RWKVP + (size_t)bh * 4096, v, q);
}
__device__ __forceinline__ void rwkv_post(const Ctx& a, bool dry, int gw, int NGW) {
    bf16_t* PROJ = (bf16_t*)(a.ws + WS_PROJ); const bf16_t* LOG = (const bf16_t*)(a.ws + WS_LOG);
    const int lane = threadIdx.x & 63, c0 = lane * 16;
    float lw[16], lb[16];
#pragma unroll
    for (int j = 0; j < 4; ++j) { const f32x4 x = *(const f32x4*)(a.in(25) + c0 + 4 * j), y = *(const f32x4*)(a.in(26) + c0 + 4 * j);
#pragma unroll
        for (int k = 0; k < 4; ++k) { lw[4 * j + k] = x[k]; lb[4 * j + k] = y[k]; } }
    for (int r0 = gw; r0 < T; r0 += 2 * NGW) {
        u32x4 yw[2][2], bw[2][2], gw4[2][2];
#pragma unroll
        for (int k = 0; k < 2; ++k) { const int row = r0 + k * NGW; if (row < T) {
            const bf16_t* yp = PROJ + (size_t)row * PW + PC_YB + c0; const bf16_t* bp = PROJ + (size_t)row * PW + PC_BV + c0; const bf16_t* gp = LOG + (size_t)row * 1024 + c0;
            yw[k][0] = *(const u32x4*)yp; yw[k][1] = *(const u32x4*)(yp + 8); bw[k][0] = *(const u32x4*)bp; bw[k][1] = *(const u32x4*)(bp + 8); gw4[k][0] = *(const u32x4*)gp; gw4[k][1] = *(const u32x4*)(gp + 8); } }
#pragma unroll
        for (int k = 0; k < 2; ++k) { const int row = r0 + k * NGW; if (row < T) {
            float y[16], bv[16], gg[16];
            { float t8[8]; unpack8(yw[k][0], t8);
#pragma unroll
              for (int j = 0; j < 8; ++j) y[j] = t8[j];
              unpack8(yw[k][1], t8);
#pragma unroll
              for (int j = 0; j < 8; ++j) y[8 + j] = t8[j];
              unpack8(bw[k][0], t8);
#pragma unroll
              for (int j = 0; j < 8; ++j) bv[j] = t8[j];
              unpack8(bw[k][1], t8);
#pragma unroll
              for (int j = 0; j < 8; ++j) bv[8 + j] = t8[j];
              unpack8(gw4[k][0], t8);
#pragma unroll
              for (int j = 0; j < 8; ++j) gg[j] = t8[j];
              unpack8(gw4[k][1], t8);
#pragma unroll
              for (int j = 0; j < 8; ++j) gg[8 + j] = t8[j]; }
            float sm = 0.f;
#pragma unroll
            for (int j = 0; j < 16; ++j) sm += y[j];
            sm += dppf<0xB1>(sm); sm += dppf<0x4E>(sm);
            const float mean = sm * (1.f / 64.f); float sv = 0.f;
#pragma unroll
            for (int j = 0; j < 16; ++j) { const float d = y[j] - mean; sv += d * d; }
            sv += dppf<0xB1>(sv); sv += dppf<0x4E>(sv);
            const float rstd = rsqrtf(sv * (1.f / 64.f) + GN_EPS);
            float o[16];
#pragma unroll
            for (int j = 0; j < 16; ++j) o[j] = ((y[j] - mean) * rstd * lw[j] + lb[j] + bv[j]) * gg[j];
            bf16_t* yp = PROJ + (size_t)row * PW + PC_YB + c0;
            u32x4 o0, o1; o0.x = pk2(o[0], o[1]); o0.y = pk2(o[2], o[3]); o0.z = pk2(o[4], o[5]); o0.w = pk2(o[6], o[7]); o1.x = pk2(o[8], o[9]); o1.y = pk2(o[10], o[11]); o1.z = pk2(o[12], o[13]); o1.w = pk2(o[14], o[15]);
            *(u32x4*)yp = dry ? yw[k][0] : o0; *(u32x4*)(yp + 8) = dry ? yw[k][1] : o1; } }
    }
}

__device__ __forceinline__ void glu_load(u32x4 (&g)[6], u32x4 (&v)[4], const bf16_t* UP, int rq, int c) {
    const int row = 4 * rq; int samp, b, t; rowinfo(row, samp, b, t);
#pragma unroll
    for (int k = 0; k < 4; ++k) { g[2 + k] = *(const u32x4*)(UP + (size_t)(row + k) * 5632 + c); v[k] = *(const u32x4*)(UP + (size_t)(row + k) * 5632 + DFF + c); }
    g[0] = (u32x4){0u, 0u, 0u, 0u}; g[1] = g[0];
    if (t >= 2) { g[0] = *(const u32x4*)(UP + (size_t)(row - 2) * 5632 + c); g[1] = *(const u32x4*)(UP + (size_t)(row - 1) * 5632 + c); }
}
__device__ __forceinline__ void glu_compute(const u32x4 (&g)[6], const u32x4 (&v)[4], int rq, int c, const float (&w)[3][8], const float (&bb)[8], const float* st, bf16_t* ACT) {
    const int row = 4 * rq; int samp, b, t; rowinfo(row, samp, b, t);
    float ug[6][8];
#pragma unroll
    for (int k = 0; k < 6; ++k) unpack8(g[k], ug[k]);
    if (samp && t < 2) {
#pragma unroll
        for (int i = 0; i < 2; ++i) { const f32x4 p0 = *(const f32x4*)(st + (size_t)(b * 2 + i) * DFF + c), p1 = *(const f32x4*)(st + (size_t)(b * 2 + i) * DFF + c + 4);
#pragma unroll
            for (int j = 0; j < 4; ++j) { ug[i][j] = p0[j]; ug[i][4 + j] = p1[j]; } }
    }
#pragma unroll
    for (int k = 0; k < 4; ++k) { float uv[8], o[8]; unpack8(v[k], uv);
#pragma unroll
        for (int j = 0; j < 8; ++j) { const float gte = bb[j] + w[0][j] * ug[k][j] + w[1][j] * ug[k + 1][j] + w[2][j] * ug[k + 2][j]; o[j] = siluf_(gte) * uv[j]; }
        *(u32x4*)(ACT + (size_t)(row + k) * DFF + c) = pack8(o); }
}
__device__ __forceinline__ void glu_phase(const Ctx& a) {
    const bf16_t* UP = (const bf16_t*)(a.ws + WS_UP); bf16_t* ACT = (bf16_t*)(a.ws + WS_ACT);
    const float* cw = a.in(31); const float* cb = a.in(32); const float* st = a.in(6);
    const int gt = blockIdx.x * 512 + threadIdx.x, NGT = gridDim.x * 512, NCOL = 352, nslab = NGT / NCOL;
    if (gt >= nslab * NCOL) return;
    const int c = (gt % NCOL) * 8, NQ = T / 4;
    float w[3][8], bb[8];
#pragma unroll
    for (int j = 0; j < 3; ++j) { const f32x4 p0 = *(const f32x4*)(cw + j * DFF + c), p1 = *(const f32x4*)(cw + j * DFF + c + 4);
#pragma unroll
        for (int k = 0; k < 4; ++k) { w[j][k] = p0[k]; w[j][4 + k] = p1[k]; } }
    { const f32x4 p0 = *(const f32x4*)(cb + c), p1 = *(const f32x4*)(cb + c + 4);
#pragma unroll
      for (int k = 0; k < 4; ++k) { bb[k] = p0[k]; bb[4 + k] = p1[k]; } }
    u32x4 gA[6], vA[4], gB[6], vB[4];
    int rq = gt / NCOL;
    if (rq < NQ) glu_load(gA, vA, UP, rq, c);
    while (rq < NQ) {
        int r2 = rq + nslab;
        if (r2 < NQ) glu_load(gB, vB, UP, r2, c);
        glu_compute(gA, vA, rq, c, w, bb, st, ACT);
        rq = r2; if (rq >= NQ) break;
        r2 = rq + nslab;
        if (r2 < NQ) glu_load(gA, vA, UP, r2, c);
        glu_compute(gB, vB, rq, c, w, bb, st, ACT);
        rq = r2;
    }
}
__device__ __forceinline__ void final_phase(const Ctx& a, bool dry) {
    const int lane = threadIdx.x & 63, gw = blockIdx.x * 8 + (threadIdx.x >> 6), NGW = gridDim.x * 8;
    const float* SS3 = (const float*)(a.ws + WS_SS3); const float* fg = a.in(34);
    for (int row = gw; row < T; row += NGW) {
        const float rs = rsqrtf(SS3[row] * (1.f / DM) + NORM_EPS);
        f32x4* o = (f32x4*)(a.out + (size_t)row * DM);
#pragma unroll
        for (int j = 0; j < 4; ++j) { const f32x4 g = ((const f32x4*)fg)[lane + 64 * j]; f32x4 v = o[lane + 64 * j]; const f32x4 vn = v * rs * g; o[lane + 64 * j] = dry ? v : vn; }
    }
}


#define XB_TMO      128
#define XB_XCNT(j)  (256  + 64 * (j))
#define XB_XSUB(j)  (1280 + 64 * (j))
#define XB_XGEN(j)  (2304 + 64 * (j))
#define XB_TOP      3328
#define XB_TOPGEN   3392
#define XCD_BAR_WORDS 3456
#define XB_SPIN_CAP (1u << 20)
__device__ __forceinline__ unsigned xb_ld(unsigned* p)              { return __hip_atomic_load(p, __ATOMIC_RELAXED, __HIP_MEMORY_SCOPE_AGENT); }
__device__ __forceinline__ unsigned xb_add(unsigned* p, unsigned v) { return __hip_atomic_fetch_add(p, v, __ATOMIC_RELAXED, __HIP_MEMORY_SCOPE_AGENT); }
__device__ __forceinline__ unsigned xb_xcc_id() { return (unsigned)__builtin_amdgcn_s_getreg((3 << 11) | 20) & 0xFu; }
#define XB_SPIN(cond, bar) do { unsigned _sp = 0; while (cond) { __builtin_amdgcn_s_sleep(1); \
    if ((++_sp & 255u) == 0u) { if (xb_ld(&(bar)[XB_TMO])) break; if (_sp > XB_SPIN_CAP) { atomicAdd(&(bar)[XB_TMO], 1u); break; } } } } while (0)
struct XcdBarrier { unsigned* bar; unsigned x; volatile LAS unsigned* st; };
__device__ __forceinline__ XcdBarrier xcd_barrier_post(unsigned* bar, volatile LAS unsigned* st) {
    XcdBarrier b; b.bar = bar; b.x = xb_xcc_id(); b.st = st;
    if (threadIdx.x == 0) (void)xb_add(&bar[XB_XCNT(b.x)], 1u);
    return b;
}
__device__ __forceinline__ void xcd_barrier_complete(unsigned* bar, unsigned x, unsigned& nloc, unsigned& nx) {
    const unsigned G = gridDim.x * gridDim.y * gridDim.z;
    unsigned sum, cnt, mine, sp = 0u;
    for (;;) {
        sum = 0u; cnt = 0u; mine = 0u;
#pragma unroll
        for (unsigned j = 0; j < 16; ++j) { const unsigned c = xb_ld(&bar[XB_XCNT(j)]); sum += c; cnt += (c > 0u) ? 1u : 0u; mine = (j == x) ? c : mine; }
        if (sum == G) break;
        __builtin_amdgcn_s_sleep(1);
        if ((++sp & 255u) == 0u) { if (xb_ld(&bar[XB_TMO])) break; if (sp > XB_SPIN_CAP) { atomicAdd(&bar[XB_TMO], 1u); break; } }
    }
    nloc = mine > 0u ? mine : 1u; nx = cnt > 0u ? cnt : 1u;
}
__device__ __forceinline__ void xcd_barrier(const XcdBarrier& b) {
    asm volatile("s_waitcnt vmcnt(0)" ::: "memory");
    __syncthreads();
    if (threadIdx.x == 0) {
        unsigned* bar = b.bar;
        __builtin_amdgcn_s_waitcnt(0);
        unsigned nloc = b.st[0], nx = b.st[1];
        if (nloc == 0u) { xcd_barrier_complete(bar, b.x, nloc, nx); b.st[0] = nloc; b.st[1] = nx; }
        const unsigned old = xb_add(&bar[XB_XSUB(b.x)], 1u);
        const unsigned gen = old / nloc;
        if (old + 1u == (gen + 1u) * nloc) {
            __builtin_amdgcn_fence(__ATOMIC_RELEASE, "agent");
            asm volatile("s_waitcnt vmcnt(0)" ::: "memory");
            const unsigned og = xb_add(&bar[XB_TOP], 1u);
            const unsigned tg = og / nx;
            if (og + 1u == (tg + 1u) * nx) xb_add(&bar[XB_TOPGEN], 1u);
            else XB_SPIN(xb_ld(&bar[XB_TOPGEN]) == tg, bar);
            __builtin_amdgcn_fence(__ATOMIC_ACQUIRE, "agent");
            xb_add(&bar[XB_XGEN(b.x)], 1u);
            asm volatile("s_waitcnt vmcnt(0)" ::: "memory");
        } else {
            XB_SPIN(xb_ld(&bar[XB_XGEN(b.x)]) == gen, bar);
            __builtin_amdgcn_fence(__ATOMIC_ACQUIRE, "agent");
            asm volatile("s_waitcnt vmcnt(0)" ::: "memory");
        }
    }
    __syncthreads();
}
#ifndef REPMASK
#define REPMASK 0
#endif
#ifndef PROBEVAR
#define PROBEVAR 0
#endif
#ifndef XSYNC
#define XSYNC 0
#endif
#ifndef DUPMASK
#define DUPMASK 0
#endif
#ifndef ONLYMODE
#define ONLYMODE 0
#endif
#ifndef SKIPM
#define SKIPM 0
#endif
__global__ void __launch_bounds__(512, 2) fwd_kernel(Args args) {
    extern __shared__ __attribute__((aligned(16))) unsigned char lds[];
    cg::grid_group grid = cg::this_grid();
    const int G = gridDim.x, bx = blockIdx.x;
    const int vcu = (G % 8 == 0) ? (bx % 8) * (G / 8) + bx / 8 : bx;
    const int lo = args.ph_lo, hi = args.ph_hi;
    {
        unsigned long long* tb = (unsigned long long*)(lds + 131072);
        if (threadIdx.x < 35) tb[threadIdx.x] = (unsigned long long)args.in[threadIdx.x];
        __syncthreads();
    }
    Ctx a; a.ws = args.ws; a.out = args.out; a.tab = (const unsigned*)(lds + 131072);
    volatile LAS unsigned* bst = (volatile LAS unsigned*)((LAS unsigned char*)lds + 131072 + 2048);
    if (threadIdx.x < 2) bst[threadIdx.x] = 0u;
    __syncthreads();
    const XcdBarrier xbar = xcd_barrier_post((unsigned*)(args.ws + WS_BAR), bst);
#define IN(k) (lo <= (k) && (k) < hi)
#define PASSES(k) _Pragma("unroll 1") for (int pass = ((REPMASK >> (k)) & 1) ? 0 : 1; pass < 2; ++pass)
#define SEAM(k) do { if (IN(k) && IN((k) + 1)) { if (lo < 0) grid.sync(); else xcd_barrier(xbar); } } while (0)
#define RUN_GEMM(MODE, AP, LDA, BP, NN, KK, EP0, EP1) do { if (ONLYMODE != 0 && ONLYMODE != MODE) break; __syncthreads(); pg8::Gemm g{(const bf16_t*)(AP), (const bf16_t*)(BP), LDA, T, NN, KK}; \
        pg8::StaticOrder S; S.init(T, NN, G, bx); Epi<MODE> E{a.ws, a.out, EP0, EP1, (int)dry}; pg8::gemm_phase<Epi<MODE>, pg8::StaticOrder>((LAS unsigned char*)lds, g, S, E); } while (0)
    if (IN(0)) PASSES(0) { if (!(SKIPM & 1)) phase0(a, lds); }
    SEAM(0);
#if XSYNC
    for (int i = 0; i < XSYNC; ++i) grid.sync();
#endif
    if (IN(1)) PASSES(1) { const bool dry = pass == 0; if (!(SKIPM & 1024)) RUN_GEMM(1, a.ws + WS_XB, DM, a.ws + WS_WIN, PW, DM, a.in(11), nullptr); if (!(SKIPM & 1)) dt_phase(a); }
    SEAM(1);
    if (IN(2)) PASSES(2) { if (!(SKIPM & 2)) { lora_prep(a); conv_prepass(a); } }
    SEAM(2);
    if (IN(3)) {
#if DUPMASK & 1
        for (int u = vcu; u < NBP * NH; u += G) ssd_prompt_unit(a, u >> 5, u & 31, lds, true);
#endif
#if DUPMASK & 2
        for (int u = vcu; u < NBS * 4; u += G) ssd_sample_unit(a, u >> 2, u & 3, lds, true);
#endif
        if (!(SKIPM & 4)) for (int u = vcu; u < NBP * NH; u += G) ssd_prompt_unit(a, u >> 5, u & 31, lds, false);
        if (!(SKIPM & 8)) for (int u = vcu; u < NBS * 4; u += G) ssd_sample_unit(a, u >> 2, u & 3, lds, false);
    }
    SEAM(3);
    if (IN(4)) { const bool dry = false;
        if (!(SKIPM & 1024)) RUN_GEMM(2, a.ws + WS_LA, 256, a.ws + WS_WLO, 3072, 256, a.in(17), a.in(19));
        { const int skip = (G > 96) ? 48 : 0;
          if (bx >= skip && !(SKIPM & 16)) ya_norm(a, dry, (bx - skip) * 512 + (int)threadIdx.x, (G - skip) * 512); } }
    SEAM(4);
    if (IN(5)) PASSES(5) { if (!(SKIPM & 32)) rwkv_scalars(a); }
    SEAM(5);
    if (IN(6)) {
#if DUPMASK & 16
        for (int u = vcu; u < NBS * 16; u += G) rwkv_sample_unit(a, u, lds);
#endif
#if DUPMASK & 32
        for (int u = vcu; u < NBP * 16 * 2; u += G) rwkv_prompt_unit<PROBEVAR>(a, u, lds);
#endif
        if (!(SKIPM & 32)) for (int u = vcu; u < NBS * 16; u += G) rwkv_sample_unit(a, u, lds);
        if (!(SKIPM & 64)) for (int u = vcu; u < NBP * 16 * 2; u += G) rwkv_prompt_unit(a, u, lds);
    }
    SEAM(6);
    if (IN(7)) { const bool dry = false;
        if (!(SKIPM & 1024)) RUN_GEMM(3, (const bf16_t*)(a.ws + WS_PROJ) + PC_Z, PW, a.ws + WS_WA, DM, DI, nullptr, nullptr);
        { const int skip = (G > 32) ? 16 : 0;
          if (bx >= skip) { if (!(SKIPM & 128)) rwkv_post(a, dry, (bx - skip) * 8 + (int)(threadIdx.x >> 6), (G - skip) * 8);
                            if (!(SKIPM & 1)) tr_run(a, lds, TR_EARLY, TR_ALL, (bx - skip) * 8 + (int)(threadIdx.x >> 6), (G - skip) * 8); } } }
    SEAM(7);
    if (IN(8)) PASSES(8) { const bool dry = pass == 0; if (!(SKIPM & 1024)) RUN_GEMM(4, (const bf16_t*)(a.ws + WS_PROJ) + PC_YB, PW, a.ws + WS_WB, DM, DM, nullptr, nullptr); }
    SEAM(8);
    if (IN(9)) PASSES(9) { const bool dry = pass == 0; if (!(SKIPM & 1024)) RUN_GEMM(5, a.ws + WS_M, DM, a.ws + WS_WOUT, DM, DM, a.in(0), a.in(1)); }
    SEAM(9);
    if (IN(10)) PASSES(10) { const bool dry = pass == 0; if (!(SKIPM & 1024)) RUN_GEMM(6, a.ws + WS_X1B, DM, a.ws + WS_WUP, 5632, DM, nullptr, nullptr); }
    SEAM(10);
    if (IN(11)) PASSES(11) { if (!(SKIPM & 256)) glu_phase(a); }
    SEAM(11);
    if (IN(12)) PASSES(12) { const bool dry = pass == 0; if (!(SKIPM & 1024)) RUN_GEMM(7, a.ws + WS_ACT, DFF, a.ws + WS_WDN, DM, DFF, nullptr, nullptr); }
    SEAM(12);
    if (IN(13)) PASSES(13) { const bool dry = pass == 0; if (!(SKIPM & 512)) final_phase(a, dry); }
#undef IN
#undef PASSES
#undef SEAM
#undef RUN_GEMM
}

#ifndef MK_SPLIT
#define MK_SPLIT 0
#endif
extern "C" void kernel_launch(void* const* d_in, const int* in_sizes, int n_in, void* d_out, int out_size, void* d_ws, size_t ws_size, hipStream_t stream) {
    static int grid = 0;
    if (grid == 0) {
        if (n_in != 35 || (size_t)out_size != O_END || ws_size < WS_END) { fprintf(stderr, "kernel_launch: unexpected shapes: n_in %d out %d ws %zu\n", n_in, out_size, ws_size); grid = -1; return; }
        int dev = 0, cus = 0, per_cu = 0;
        hipGetDevice(&dev); hipDeviceGetAttribute(&cus, hipDeviceAttributeMultiprocessorCount, dev);
        hipFuncSetAttribute((const void*)fwd_kernel, hipFuncAttributeMaxDynamicSharedMemorySize, LDS_BYTES);
        hipOccupancyMaxActiveBlocksPerMultiprocessor(&per_cu, (const void*)fwd_kernel, 512, LDS_BYTES);
        if (per_cu < 1) per_cu = 1;
        grid = cus * per_cu;
        (void)hipGetLastError();
    }
    if (grid < 0) return;
    if (hipMemsetAsync((char*)d_ws + WS_BAR, 0, XCD_BAR_WORDS * 4, stream) != hipSuccess) { fprintf(stderr, "kernel_launch: memset failed\n"); return; }
    Args a{};
    for (int i = 0; i < 35; ++i) a.in[i] = (const float*)d_in[i];
    a.out = (float*)d_out; a.ws = (unsigned char*)d_ws; a.rep = REPMASK;
#if MK_SPLIT
    for (int ph = 0; ph < NPHASE; ++ph) { a.ph_lo = ph; a.ph_hi = ph + 1; void* args[] = {&a};
        hipError_t e = hipLaunchCooperativeKernel((const void*)fwd_kernel, dim3(grid), dim3(512), args, LDS_BYTES, stream);
        if (e != hipSuccess) { fprintf(stderr, "launch failed: %s\n", hipGetErrorString(e)); break; } }
#else
    a.ph_lo = 0; a.ph_hi = NPHASE; void* args[] = {&a};
    hipError_t e = hipLaunchCooperativeKernel((const void*)fwd_kernel, dim3(grid), dim3(512), args, LDS_BYTES, stream);
    if (e != hipSuccess) fprintf(stderr, "cooperative launch failed: %s (grid %d)\n", hipGetErrorString(e), grid);
#endif
}
```

```cpp
#include <hip/hip_runtime.h>
#include <hip/hip_cooperative_groups.h>
#include <cstdio>
#include <cstdint>
namespace cg = cooperative_groups;

#define LAS __attribute__((address_space(3)))
typedef unsigned short bf16_t;
typedef short bf16x8 __attribute__((ext_vector_type(8)));
typedef float f32x4 __attribute__((ext_vector_type(4)));
typedef unsigned u32x4 __attribute__((ext_vector_type(4)));
typedef unsigned u32x2 __attribute__((ext_vector_type(2)));

constexpr int DM = 1024, TP = 16384, TSMP = 1024, T = TP + TSMP, SEQ = 2048, DSEQ = 8, NBP = 8, NBS = 128;
constexpr int DI = 2048, CD = 3072, NH = 32, NS = 128, RSD = 3328, DFF = 2816;
constexpr int N1 = 10752, PW = 10496;
constexpr int PC_Z = 0, PC_XBC = 2048, PC_RW = 5120, PC_GT = 8448, PC_DT = 10496;
constexpr int PC_YB = 2048, PC_BV = 3072;
constexpr float NORM_EPS = 1e-5f, GN_EPS = 64e-5f;
constexpr size_t O_YP = 0, O_YS = (size_t)TP * DM, O_CONVP = O_YS + (size_t)TSMP * DM, O_SSMP = O_CONVP + (size_t)NBP * 3 * CD,
    O_SHIFTP = O_SSMP + (size_t)NBP * NH * 64 * NS, O_RWKVP = O_SHIFTP + (size_t)NBP * RSD, O_FFNP = O_RWKVP + (size_t)NBP * 16 * 64 * 64,
    O_CONVS = O_FFNP + (size_t)NBP * 2 * DFF, O_SSMS = O_CONVS + (size_t)NBS * 3 * CD, O_SHIFTS = O_SSMS + (size_t)NBS * NH * 64 * NS,
    O_RWKVS = O_SHIFTS + (size_t)NBS * RSD, O_FFNS = O_RWKVS + (size_t)NBS * 16 * 64 * 64, O_END = O_FFNS + (size_t)NBS * 2 * DFF;
constexpr size_t MiB = 1u << 20, U34 = 34 * MiB;
constexpr size_t WS_SSA = 0, WS_SS2 = WS_SSA + (size_t)T * 16, WS_SS3 = WS_SS2 + (size_t)T * 4, WS_RSTD1 = WS_SS3 + (size_t)T * 4;
constexpr size_t WS_BAR = 512 * 1024;
constexpr size_t WS_WIN = 1 * MiB, WS_WA = 22 * MiB, WS_WB = 26 * MiB, WS_WOUT = 28 * MiB, WS_WUP = 30 * MiB, WS_WDN = 41 * MiB, WS_WLO = 46 * MiB + 512 * 1024;
constexpr size_t WS_XB = 48 * MiB, WS_LOE = WS_XB, WS_PROJ = 82 * MiB, WS_DT = 431 * MiB, WS_LA = 434 * MiB, WS_LOA = 443 * MiB, WS_LOG = 477 * MiB;
constexpr size_t WS_XC = WS_LOA, WS_BC = WS_XB, WS_RWS = WS_LA;
constexpr size_t WS_MA = WS_LOA, WS_M = WS_LOG, WS_X1 = 82 * MiB, WS_X1B = 150 * MiB, WS_UP = 184 * MiB, WS_ACT = 371 * MiB, WS_END = 511 * MiB;
static_assert(WS_RSTD1 + (size_t)T * 4 <= WS_WIN && WS_PROJ + (size_t)T * PW * 2 <= WS_DT && WS_UP + (size_t)T * 5632 * 2 <= WS_ACT && WS_ACT + (size_t)T * DFF * 2 <= WS_END, "ws map");
constexpr int LDS_BYTES = 135168;
constexpr int NPHASE = 14;

__device__ __forceinline__ float bf2f(bf16_t u) { return __builtin_bit_cast(float, (unsigned)u << 16); }
__device__ __forceinline__ unsigned f2bf(float f) { unsigned u = __builtin_bit_cast(unsigned, f); return (u + 0x7fffu + ((u >> 16) & 1u)) >> 16; }
__device__ __forceinline__ unsigned pk2(float lo, float hi) { unsigned r; asm("v_cvt_pk_bf16_f32 %0, %1, %2" : "=v"(r) : "v"(lo), "v"(hi)); return r; }
__device__ __forceinline__ float lo16(unsigned w) { return __builtin_bit_cast(float, w << 16); }
__device__ __forceinline__ float hi16(unsigned w) { return __builtin_bit_cast(float, w & 0xffff0000u); }
__device__ __forceinline__ float sigmoidf_(float x) { return 1.f / (1.f + __expf(-x)); }
__device__ __forceinline__ float siluf_(float x) { return x / (1.f + __expf(-x)); }
__device__ __forceinline__ float softplusf_(float x) { return x > 20.f ? x : __logf(1.f + __expf(x)); }
__device__ __forceinline__ void rowinfo(int row, int& samp, int& b, int& t) {
    if (row < TP) { samp = 0; b = row >> 11; t = row & 2047; } else { const int r = row - TP; samp = 1; b = r >> 3; t = r & 7; }
}
__device__ __forceinline__ void lds_barrier() { asm volatile("s_waitcnt lgkmcnt(0)\n\ts_barrier" ::: "memory"); }
template <int CTRL> __device__ __forceinline__ float dppf(float v) { return __builtin_bit_cast(float, __builtin_amdgcn_update_dpp(0, __builtin_bit_cast(int, v), CTRL, 0xF, 0xF, true)); }
__device__ __forceinline__ float wave_sum(float v) {
    v += dppf<0xB1>(v); v += dppf<0x4E>(v); v += dppf<0x141>(v); v += dppf<0x140>(v);
    const int iv = __builtin_bit_cast(int, v);
    return (__builtin_bit_cast(float, __builtin_amdgcn_readlane(iv, 0)) + __builtin_bit_cast(float, __builtin_amdgcn_readlane(iv, 16))) +
           (__builtin_bit_cast(float, __builtin_amdgcn_readlane(iv, 32)) + __builtin_bit_cast(float, __builtin_amdgcn_readlane(iv, 48)));
}
__device__ __forceinline__ float sum8(float v) { v += dppf<0xB1>(v); v += dppf<0x4E>(v); v += dppf<0x141>(v); return v; }

struct Args { const float* in[35]; float* out; unsigned char* ws; int ph_lo, ph_hi, rep, pad; };
struct Ctx {
    unsigned char* ws; float* out; const unsigned* tab;
    __device__ __forceinline__ const float* in(int i) const {
        const unsigned lo = __builtin_amdgcn_readfirstlane(tab[2 * i]), hi = __builtin_amdgcn_readfirstlane(tab[2 * i + 1]);
        return (const float*)(((unsigned long long)hi << 32) | lo);
    }
};

namespace pg8 {
constexpr int BM = 256, BK = 64, HALF = 128, HTB = HALF * BK * 2, NXCD = 8, WGM = 8;
__host__ __device__ __forceinline__ int lds_byte(int r, int c) { const int st = (r >> 4) * 2 + (c >> 5), rr = r & 15, cc = c & 31, ob = rr * 64 + cc * 2; return st * 1024 + (ob ^ (((ob >> 9) & 1) << 5)); }
__host__ __device__ __forceinline__ void stage_rc(int b, int& R, int& C) { const int st = b / 1024, sb = b % 1024, swz = sb ^ (((sb >> 9) & 1) << 5); R = (st >> 1) * 16 + swz / 64; C = (st & 1) * 32 + (swz % 64) / 2; }
__host__ __device__ __forceinline__ int perm32(int rho) { const int n = rho >> 4, i = rho & 15; return 8 * (i >> 2) + 4 * n + (i & 3); }
struct Unit { int pm, pn; };
struct Gemm { const bf16_t* A; const bf16_t* Bt; int lda, M, N, K; };
struct StaticOrder {
    int nM, nN, nwg, G, c;
    __device__ void init(int M, int N, int G_, int c_) { nM = M / BM; nN = N / BM; nwg = nM * nN; G = G_; c = c_; }
    __device__ bool next(int i, Unit& u) const {
        const long L = (long)i * G + c; if (L >= nwg) return false;
        int wgid = (int)L; { const int q = nwg / NXCD, r = nwg % NXCD, xcd = wgid % NXCD, off = wgid / NXCD; wgid = (xcd < r ? xcd * (q + 1) : r * (q + 1) + (xcd - r) * q) + off; }
        const int nig = WGM * nN, gid = wgid / nig, fm = gid * WGM, gsz = (nM - fm) < WGM ? (nM - fm) : WGM;
        u.pm = fm + ((wgid % nig) % gsz); u.pn = (wgid % nig) / gsz; return true;
    }
};

template <class Epi, class Sched>
__device__ __forceinline__ void gemm_phase(LAS unsigned char* lds, const Gemm g, const Sched& S, const Epi& E) {
    const int tid = threadIdx.x, wid = __builtin_amdgcn_readfirstlane(tid >> 6), lane = tid & 63, wr = wid >> 2, wc = wid & 3, fr = lane & 15, fq = lane >> 4;
    const int K = g.K, nt = K / BK;
    unsigned voffA[2], voffB[2];
#pragma unroll
    for (int i = 0; i < 2; ++i) { int R, C; stage_rc(tid * 16 + i * 8192, R, C); const int Rb = (R & ~31) + perm32(R & 31);
        voffA[i] = (unsigned)(R * g.lda + C) * 2u; voffB[i] = (unsigned)(Rb * K + C) * 2u; }
    const size_t kstep = (size_t)(BK * 2);
    const size_t hstepA = (size_t)HALF * g.lda * 2, hstepB = (size_t)HALF * K * 2;
    const size_t tstepA = 2 * hstepA, tstepB = 2 * hstepB;
    const unsigned ldsw = (unsigned)wid * 1024u;
    const int aoff = lds_byte(wr * 64 + fr, fq * 8), boff = lds_byte(wc * 32 + fr, fq * 8);
#define PG8_SA(b, h) (((b) * 2 + (h)) * HTB)
#define PG8_SB(b, h) ((4 + (b) * 2 + (h)) * HTB)
#define PG8_STAGE(bufoff, gbase, voff) do { _Pragma("unroll") for (int _i = 0; _i < 2; ++_i) \
        __builtin_amdgcn_global_load_lds((const unsigned*)((const char*)(gbase) + (voff)[_i]), (LAS unsigned*)(lds + (bufoff) + ldsw + _i * 8192), 16, 0, 0); } while (0)
#define PG8_LDA(dst, b, h) do { _Pragma("unroll") for (int m = 0; m < 4; ++m) _Pragma("unroll") for (int k = 0; k < 2; ++k) dst[m][k] = *(const LAS bf16x8*)(lds + PG8_SA(b, h) + aoff + m * 2048 + k * 1024); } while (0)
#define PG8_LDB(dst, b, h) do { _Pragma("unroll") for (int n = 0; n < 2; ++n) _Pragma("unroll") for (int k = 0; k < 2; ++k) dst[n][k] = *(const LAS bf16x8*)(lds + PG8_SB(b, h) + boff + n * 2048 + k * 1024); } while (0)
#define PG8_MMA(ai, bj, At, Bt) do { __builtin_amdgcn_s_setprio(1); _Pragma("unroll") for (int m = 0; m < 4; ++m) _Pragma("unroll") for (int n = 0; n < 2; ++n) _Pragma("unroll") for (int k = 0; k < 2; ++k) \
        acc[ai][bj][m][n] = __builtin_amdgcn_mfma_f32_16x16x32_bf16(Bt[n][k], At[m][k], acc[ai][bj][m][n], 0, 0, 0); __builtin_amdgcn_s_setprio(0); } while (0)
#define PG8_WAIT_V(n) asm volatile("s_waitcnt vmcnt(" #n ")" ::: "memory")
#define PG8_WAIT_L(n) asm volatile("s_waitcnt lgkmcnt(" #n ")" ::: "memory")
#define PG8_BAR __builtin_amdgcn_s_barrier()
#define PG8_SCHED __builtin_amdgcn_sched_barrier(0)
    Unit cur, nxt; int ui = 0;
    if (!S.next(0, cur)) return;
    f32x4 acc[2][2][4][2];
#pragma unroll
    for (int a = 0; a < 2; ++a)
#pragma unroll
        for (int b = 0; b < 2; ++b)
#pragma unroll
            for (int m = 0; m < 4; ++m)
#pragma unroll
                for (int n = 0; n < 2; ++n) acc[a][b][m][n] = (f32x4){0.f, 0.f, 0.f, 0.f};
    bf16x8 At[4][2], B0[2][2], B1[2][2];
    const char* cA = (const char*)g.A + (size_t)cur.pm * tstepA; const char* cB = (const char*)g.Bt + (size_t)cur.pn * tstepB;
    PG8_STAGE(PG8_SB(0, 0), cB, voffB); PG8_STAGE(PG8_SB(0, 1), cB + hstepB, voffB); PG8_STAGE(PG8_SA(0, 0), cA, voffA); PG8_STAGE(PG8_SA(0, 1), cA + hstepA, voffA);
    if (wr == 1) PG8_BAR;
    PG8_WAIT_V(2); PG8_BAR;
    PG8_STAGE(PG8_SB(1, 0), cB + kstep, voffB); PG8_STAGE(PG8_SA(1, 0), cA + kstep, voffA); PG8_STAGE(PG8_SB(1, 1), cB + hstepB + kstep, voffB);
    PG8_WAIT_V(6); PG8_BAR;
    for (;;) {
        const bool has_next = S.next(ui + 1, nxt);
        const char* nA = has_next ? (const char*)g.A + (size_t)nxt.pm * tstepA : cA; const char* nB = has_next ? (const char*)g.Bt + (size_t)nxt.pn * tstepB : cB;
#pragma unroll 1
        for (int t = 0; t < nt; t += 2) {
            const bool last = (t == nt - 2);
            const char* a1 = cA + (size_t)(t + 1) * kstep;
            const char* a2 = last ? nA : cA + (size_t)(t + 2) * kstep; const char* b2 = last ? nB : cB + (size_t)(t + 2) * kstep;
            const char* a3 = a2 + kstep; const char* b3 = b2 + kstep;
            PG8_LDB(B0, 0, 0); PG8_LDB(B1, 0, 1); PG8_SCHED; PG8_LDA(At, 0, 0); PG8_STAGE(PG8_SA(1, 1), a1 + hstepA, voffA);
            PG8_WAIT_V(8); PG8_WAIT_L(0); PG8_BAR; PG8_MMA(0, 0, At, B0); PG8_MMA(0, 1, At, B1); PG8_BAR; PG8_SCHED;
            PG8_LDA(At, 0, 1); PG8_STAGE(PG8_SB(0, 0), b2, voffB); PG8_STAGE(PG8_SB(0, 1), b2 + hstepB, voffB); PG8_STAGE(PG8_SA(0, 0), a2, voffA);
            PG8_WAIT_V(8); PG8_WAIT_L(0); PG8_BAR; PG8_MMA(1, 0, At, B0); PG8_MMA(1, 1, At, B1); PG8_BAR; PG8_SCHED;
            PG8_LDB(B0, 1, 0); PG8_LDB(B1, 1, 1); PG8_SCHED; PG8_LDA(At, 1, 0); PG8_STAGE(PG8_SA(0, 1), a2 + hstepA, voffA);
            PG8_WAIT_V(8); PG8_WAIT_L(0); PG8_BAR; PG8_MMA(0, 0, At, B0); PG8_MMA(0, 1, At, B1); PG8_BAR; PG8_SCHED;
            PG8_LDA(At, 1, 1); PG8_STAGE(PG8_SB(1, 0), b3, voffB); PG8_STAGE(PG8_SB(1, 1), b3 + hstepB, voffB); PG8_STAGE(PG8_SA(1, 0), a3, voffA);
            PG8_WAIT_V(8); PG8_WAIT_L(0); PG8_BAR; PG8_MMA(1, 0, At, B0); PG8_MMA(1, 1, At, B1); PG8_BAR; PG8_SCHED;
        }
        if (wr == 0) PG8_BAR;
        E(acc, cur, wr, wc, fr, fq);
        if (!has_next) break;
#pragma unroll
        for (int a = 0; a < 2; ++a)
#pragma unroll
            for (int b = 0; b < 2; ++b)
#pragma unroll
                for (int m = 0; m < 4; ++m)
#pragma unroll
                    for (int n = 0; n < 2; ++n) acc[a][b][m][n] = (f32x4){0.f, 0.f, 0.f, 0.f};
        cur = nxt; cA = nA; cB = nB; ++ui;
        if (wr == 1) PG8_BAR;
    }
    PG8_WAIT_V(0);
    PG8_BAR;
#undef PG8_SA
#undef PG8_SB
#undef PG8_STAGE
#undef PG8_LDA
#undef PG8_LDB
#undef PG8_MMA
#undef PG8_WAIT_V
#undef PG8_WAIT_L
#undef PG8_BAR
#undef PG8_SCHED
}
}

__device__ __forceinline__ void st8bf(bf16_t* p, f32x4 a, f32x4 b) { u32x4 w; w.x = pk2(a[0], a[1]); w.y = pk2(a[2], a[3]); w.z = pk2(b[0], b[1]); w.w = pk2(b[2], b[3]); *(u32x4*)p = w; }

template <int SEG> __device__ __forceinline__ void epi1_seg(const f32x4 (&acc)[2][2][4][2], const pg8::Unit& u, int wr, int wc, int fr, int fq, unsigned char* ws, float* out, const float* dtb) {
    const int rbase = u.pm * 256 + wr * 64 + fr, cbase = u.pn * 256 + wc * 32 + 8 * fq;
    bf16_t* PROJ = (bf16_t*)(ws + WS_PROJ);
#pragma unroll
    for (int ai = 0; ai < 2; ++ai)
#pragma unroll
        for (int m = 0; m < 4; ++m) {
            const int row = rbase + ai * 128 + m * 16;
            int samp, b, t; rowinfo(row, samp, b, t);
            const int L = samp ? DSEQ : SEQ;
            const float rs = ((const float*)(ws + WS_RSTD1))[row];
#pragma unroll
            for (int bj = 0; bj < 2; ++bj) {
                const int col = cbase + bj * 128;
                f32x4 v0 = acc[ai][bj][m][0] * rs, v1 = acc[ai][bj][m][1] * rs;
                if (SEG == 0) {
#pragma unroll
                    for (int i = 0; i < 4; ++i) { v0[i] = siluf_(v0[i]); v1[i] = siluf_(v1[i]); }
                    st8bf(PROJ + (size_t)row * PW + col, v0, v1);
                } else if (SEG == 1) {
                    st8bf(PROJ + (size_t)row * PW + col, v0, v1);
                    if (t >= L - 3) { float* o = out + (samp ? O_CONVS : O_CONVP) + (size_t)(b * 3 + (t - (L - 3))) * CD + (col - PC_XBC); *(f32x4*)o = v0; *(f32x4*)(o + 4) = v1; }
                } else if (SEG == 2) {
                    st8bf(PROJ + (size_t)row * PW + col, v0, v1);
                    if (t == L - 1) { float* o = out + (samp ? O_SHIFTS : O_SHIFTP) + (size_t)b * RSD + (col - PC_RW); *(f32x4*)o = v0; *(f32x4*)(o + 4) = v1; }
                } else if (SEG == 3) {
#pragma unroll
                    for (int i = 0; i < 4; ++i) { v0[i] = sigmoidf_(v0[i]); v1[i] = sigmoidf_(v1[i]); }
                    st8bf(PROJ + (size_t)row * PW + col, v0, v1);
                } else {
                    if (col < PC_DT + 32) {
                        const int c = col - PC_DT; float* d = (float*)(ws + WS_DT) + (size_t)row * 32 + c;
                        const f32x4 b0 = *(const f32x4*)(dtb + c), b1 = *(const f32x4*)(dtb + c + 4);
                        f32x4 o0, o1;
#pragma unroll
                        for (int i = 0; i < 4; ++i) { o0[i] = softplusf_(v0[i] + b0[i]); o1[i] = softplusf_(v1[i] + b1[i]); }
                        *(f32x4*)d = o0; *(f32x4*)(d + 4) = o1;
                    }
                }
            }
        }
}

template <int SEG> __device__ __forceinline__ void epi2_seg(const f32x4 (&acc)[2][2][4][2], const pg8::Unit& u, int wr, int wc, int fr, int fq, unsigned char* ws, const float* bias) {
    const int rbase = u.pm * 256 + wr * 64 + fr, cbase = (u.pn & 3) * 256 + wc * 32 + 8 * fq;
    bf16_t* O = (bf16_t*)(ws + (SEG == 0 ? WS_LOE : SEG == 1 ? WS_LOA : WS_LOG));
#pragma unroll
    for (int bj = 0; bj < 2; ++bj) {
        const int c = cbase + bj * 128;
        f32x4 b0 = {0.f, 0.f, 0.f, 0.f}, b1 = {0.f, 0.f, 0.f, 0.f};
        if (SEG < 2) { b0 = *(const f32x4*)(bias + c); b1 = *(const f32x4*)(bias + c + 4); }
#pragma unroll
        for (int ai = 0; ai < 2; ++ai)
#pragma unroll
            for (int m = 0; m < 4; ++m) {
                const int row = rbase + ai * 128 + m * 16;
                f32x4 v0 = acc[ai][bj][m][0], v1 = acc[ai][bj][m][1];
                if (SEG == 0) {
#pragma unroll
                    for (int i = 0; i < 4; ++i) { v0[i] = sigmoidf_(v0[i] + b0[i]) * 0.6065306597f; v1[i] = sigmoidf_(v1[i] + b1[i]) * 0.6065306597f; }
                } else if (SEG == 1) {
#pragma unroll
                    for (int i = 0; i < 4; ++i) { v0[i] = sigmoidf_(v0[i] + b0[i]); v1[i] = sigmoidf_(v1[i] + b1[i]); }
                }
                st8bf(O + (size_t)row * 1024 + c, v0, v1);
            }
    }
}
template <int MODE> struct Epi {
    static constexpr int mode = MODE; unsigned char* ws; float* out; const float* p0; const float* p1; int dry;
    __device__ __forceinline__ void operator()(const f32x4 (&acc)[2][2][4][2], const pg8::Unit& u, int wr, int wc, int fr, int fq) const {
        if (mode == 1) {
            if (u.pn < 8) epi1_seg<0>(acc, u, wr, wc, fr, fq, ws, out, p0); else if (u.pn < 20) epi1_seg<1>(acc, u, wr, wc, fr, fq, ws, out, p0);
            else if (u.pn < 33) epi1_seg<2>(acc, u, wr, wc, fr, fq, ws, out, p0); else if (u.pn < 41) epi1_seg<3>(acc, u, wr, wc, fr, fq, ws, out, p0);
            else epi1_seg<4>(acc, u, wr, wc, fr, fq, ws, out, p0);
            return;
        }
        if (mode == 2) {
            if (u.pn < 4) epi2_seg<0>(acc, u, wr, wc, fr, fq, ws, p0); else if (u.pn < 8) epi2_seg<1>(acc, u, wr, wc, fr, fq, ws, p1); else epi2_seg<2>(acc, u, wr, wc, fr, fq, ws, p0);
            return;
        }
        const int rbase = u.pm * 256 + wr * 64 + fr, cbase = u.pn * 256 + wc * 32 + 8 * fq;
        bf16_t* PROJ = (bf16_t*)(ws + WS_PROJ);
#pragma unroll
        for (int ai = 0; ai < 2; ++ai)
#pragma unroll
            for (int m = 0; m < 4; ++m) {
                const int row = rbase + ai * 128 + m * 16;
                int samp, b, t; rowinfo(row, samp, b, t);
                const int L = samp ? DSEQ : SEQ;
                float rs = 1.f;
                if (mode == 1) rs = ((const float*)(ws + WS_RSTD1))[row];
                else if (mode == 6) rs = rsqrtf(((const float*)(ws + WS_SS2))[row] * (1.f / DM) + NORM_EPS);
                float ssq = 0.f;
#pragma unroll
                for (int bj = 0; bj < 2; ++bj) {
                    const int col = cbase + bj * 128;
                    f32x4 v0 = acc[ai][bj][m][0] * rs, v1 = acc[ai][bj][m][1] * rs;
                    if (mode == 3 || mode == 4) {
                        const u32x4 gw = *(const u32x4*)(PROJ + (size_t)row * PW + PC_GT + (mode == 4 ? 1024 : 0) + col);
                        f32x4 g0 = {lo16(gw.x), hi16(gw.x), lo16(gw.y), hi16(gw.y)}, g1 = {lo16(gw.z), hi16(gw.z), lo16(gw.w), hi16(gw.w)};
                        v0 = v0 * g0; v1 = v1 * g1;
                        if (mode == 3) st8bf((bf16_t*)(ws + WS_MA) + (size_t)row * 1024 + col, v0, v1);
                        else {
                            const u32x4 mw = *(const u32x4*)((const bf16_t*)(ws + WS_MA) + (size_t)row * 1024 + col);
                            f32x4 m0 = {lo16(mw.x), hi16(mw.x), lo16(mw.y), hi16(mw.y)}, m1 = {lo16(mw.z), hi16(mw.z), lo16(mw.w), hi16(mw.w)};
                            st8bf((bf16_t*)(ws + WS_M) + (size_t)row * 1024 + col, v0 + m0, v1 + m1);
                        }
                    } else if (mode == 5) {
                        const float* xr = (row < TP ? p0 + (size_t)row * DM : p1 + (size_t)(row - TP) * DM) + col;
                        v0 = v0 + *(const f32x4*)xr; v1 = v1 + *(const f32x4*)(xr + 4);
                        st8bf((bf16_t*)(ws + WS_X1B) + (size_t)row * DM + col, v0, v1);
#pragma unroll
                        for (int i = 0; i < 4; ++i) ssq += v0[i] * v0[i] + v1[i] * v1[i];
                    } else if (mode == 6) {
                        st8bf((bf16_t*)(ws + WS_UP) + (size_t)row * 5632 + col, v0, v1);
                        if (col < DFF && t >= L - 2) { float* o = out + (samp ? O_FFNS : O_FFNP) + (size_t)(b * 2 + (t - (L - 2))) * DFF + col; *(f32x4*)o = v0; *(f32x4*)(o + 4) = v1; }
                    } else {
                        const u32x4 xw = *(const u32x4*)((const bf16_t*)(ws + WS_X1B) + (size_t)row * DM + col);
                        v0 = v0 + (f32x4){lo16(xw.x), hi16(xw.x), lo16(xw.y), hi16(xw.y)}; v1 = v1 + (f32x4){lo16(xw.z), hi16(xw.z), lo16(xw.w), hi16(xw.w)};
                        float* o = out + (size_t)row * DM + col; *(f32x4*)o = v0; *(f32x4*)(o + 4) = v1;
#pragma unroll
                        for (int i = 0; i < 4; ++i) ssq += v0[i] * v0[i] + v1[i] * v1[i];
                    }
                }
                if (mode == 5 || mode == 7) {
                    ssq += __shfl_xor(ssq, 16); ssq += __shfl_xor(ssq, 32);
                    if (fq == 0) atomicAdd((float*)(ws + (mode == 5 ? WS_SS2 : WS_SS3)) + row, dry ? 0.f : ssq);
                }
            }
    }
};

struct TrItem { const float* W; int N, k0, n0; bf16_t* WT; int ldk, drow, dk; const float* kscale; };
constexpr int TR_EARLY = 16 * 329 + 32 * 32 + 16 * 32 + 32 + 32 + 64, TR_ALL = TR_EARLY + 16 * 32 + 16 * 176 + 44 * 32;
__device__ __forceinline__ TrItem tr_item(const Ctx& a, int it) {
    constexpr int I_IN = 16 * 329, I_A = 32 * 32, I_B = 16 * 32, I_O = 16 * 32, I_UP = 16 * 176, I_LW = 32, I_LA = 32, I_LG = 64;
    unsigned char* ws = a.ws; int r = it;
    if (r < I_IN) { const int kb = r / 329, nb = r % 329, n0 = 32 * nb; const int d = n0 < 5120 ? n0 : (n0 < 5152 ? PC_DT + (n0 - 5120) : n0 - 32);
        return TrItem{a.in(8), 10528, 64 * kb, n0, (bf16_t*)(ws + WS_WIN), 1024, d, 64 * kb, a.in(7)}; } r -= I_IN;
    if (r < I_A) return TrItem{a.in(15), 1024, 64 * (r / 32), 32 * (r % 32), (bf16_t*)(ws + WS_WA), 2048, 32 * (r % 32), 64 * (r / 32), nullptr}; r -= I_A;
    if (r < I_B) return TrItem{a.in(27), 1024, 64 * (r / 32), 32 * (r % 32), (bf16_t*)(ws + WS_WB), 1024, 32 * (r % 32), 64 * (r / 32), nullptr}; r -= I_B;
    if (r < I_LW) return TrItem{a.in(18), 1024, 0, 32 * r, (bf16_t*)(ws + WS_WLO), 256, 32 * r, 0, nullptr}; r -= I_LW;
    if (r < I_LA) return TrItem{a.in(20), 1024, 0, 32 * r, (bf16_t*)(ws + WS_WLO), 256, 1024 + 32 * r, 64, nullptr}; r -= I_LA;
    if (r < I_LG) return TrItem{a.in(21), 1024, 64 * (r / 32), 32 * (r % 32), (bf16_t*)(ws + WS_WLO), 256, 2048 + 32 * (r % 32), 128 + 64 * (r / 32), nullptr}; r -= I_LG;
    if (r < I_O) return TrItem{a.in(28), 1024, 64 * (r / 32), 32 * (r % 32), (bf16_t*)(ws + WS_WOUT), 1024, 32 * (r % 32), 64 * (r / 32), nullptr}; r -= I_O;
    if (r < I_UP) return TrItem{a.in(30), 5632, 64 * (r / 176), 32 * (r % 176), (bf16_t*)(ws + WS_WUP), 1024, 32 * (r % 176), 64 * (r / 176), a.in(29)}; r -= I_UP;
    return TrItem{a.in(33), 1024, 64 * (r / 32), 32 * (r % 32), (bf16_t*)(ws + WS_WDN), 2816, 32 * (r % 32), 64 * (r / 32), nullptr};
}
__device__ __forceinline__ void tr_load(const TrItem& d, float (&v)[32], float (&sc)[32], int lane) {
#pragma unroll
    for (int i = 0; i < 32; ++i) { const int kk = 2 * i + (lane >> 5); v[i] = d.W[(size_t)(d.k0 + kk) * d.N + d.n0 + (lane & 31)]; sc[i] = d.kscale ? d.kscale[d.k0 + kk] : 1.f; }
}
__device__ __forceinline__ void tr_store(const TrItem& d, const float (&v)[32], const float (&sc)[32], float* scr, int lane) {
#pragma unroll
    for (int i = 0; i < 32; ++i) { const int kk = 2 * i + (lane >> 5); scr[kk * 33 + (lane & 31)] = v[i] * sc[i]; }
    asm volatile("s_waitcnt lgkmcnt(0)" ::: "memory");
    const int c = lane & 7;
#pragma unroll
    for (int j = 0; j < 4; ++j) { const int n = (lane >> 3) + 8 * j; const float* s = scr + (8 * c) * 33 + n;
        u32x4 o; o.x = pk2(s[0 * 33], s[1 * 33]); o.y = pk2(s[2 * 33], s[3 * 33]); o.z = pk2(s[4 * 33], s[5 * 33]); o.w = pk2(s[6 * 33], s[7 * 33]);
        *(u32x4*)(d.WT + (size_t)(d.drow + n) * d.ldk + d.dk + 8 * c) = o; }
    asm volatile("s_waitcnt lgkmcnt(0)" ::: "memory");
}
__device__ __forceinline__ void tr_run(const Ctx& a, unsigned char* lds, int first, int NIT, int w0, int NGW) {
    const int lane = threadIdx.x & 63, wave = threadIdx.x >> 6;
    float* scr = (float*)(lds + wave * 16384);
    {
        float vA[32], sA[32], vB[32], sB[32];
        int it = first + w0;
        if (it < NIT) { const TrItem d = tr_item(a, it); tr_load(d, vA, sA, lane); }
        while (it < NIT) {
            int it2 = it + NGW;
            if (it2 < NIT) { const TrItem d = tr_item(a, it2); tr_load(d, vB, sB, lane); }
            { const TrItem d = tr_item(a, it); tr_store(d, vA, sA, scr, lane); }
            it = it2; if (it >= NIT) break;
            it2 = it + NGW;
            if (it2 < NIT) { const TrItem d = tr_item(a, it2); tr_load(d, vA, sA, lane); }
            { const TrItem d = tr_item(a, it); tr_store(d, vB, sB, scr, lane); }
            it = it2;
        }
    }
}
__device__ __forceinline__ void phase0(const Ctx& a, unsigned char* lds) {
    const int tid = threadIdx.x, lane = tid & 63, wave = tid >> 6;
    const int gw = blockIdx.x * 8 + wave, NGW = gridDim.x * 8;
    unsigned char* ws = a.ws;
    tr_run(a, lds, 0, TR_EARLY, gw, NGW);
    const int gt = blockIdx.x * 512 + tid, NGT = gridDim.x * 512;
    const u32x4 z4 = {0u, 0u, 0u, 0u};
    for (int i = gt; i < 224 * 128; i += NGT) *(u32x4*)(ws + WS_WIN + (size_t)10528 * 2048 + (size_t)i * 16) = z4;
    for (int i = gt; i < 3072 * 32; i += NGT) { const int row = i >> 5, c8 = (i & 31) * 8, seg = row >> 10;
        const bool nz = (seg == 0) ? (c8 < 64) : (seg == 1) ? (c8 >= 64 && c8 < 128) : (c8 >= 128);
        if (!nz) *(u32x4*)(ws + WS_WLO + ((size_t)row * 256 + c8) * 2) = z4; }
    for (int i = gt; i < T * 6; i += NGT) ((float*)(ws + WS_SSA))[i] = 0.f;
    for (int r0 = gw; r0 < T; r0 += 2 * NGW) {
        f32x4 v[2][4];
#pragma unroll
        for (int k = 0; k < 2; ++k) { const int row = r0 + k * NGW; if (row < T) {
            const float* xr = row < TP ? a.in(0) + (size_t)row * DM : a.in(1) + (size_t)(row - TP) * DM;
#pragma unroll
            for (int j = 0; j < 4; ++j) v[k][j] = ((const f32x4*)xr)[lane + 64 * j]; } }
#pragma unroll
        for (int k = 0; k < 2; ++k) { const int row = r0 + k * NGW; if (row < T) {
            float s = 0.f;
#pragma unroll
            for (int j = 0; j < 4; ++j) s += v[k][j][0] * v[k][j][0] + v[k][j][1] * v[k][j][1] + v[k][j][2] * v[k][j][2] + v[k][j][3] * v[k][j][3];
            s = wave_sum(s);
            if (lane == 0) ((float*)(ws + WS_RSTD1))[row] = rsqrtf(s * (1.f / DM) + NORM_EPS);
            u32x2* o = (u32x2*)(ws + WS_XB + (size_t)row * DM * 2);
#pragma unroll
            for (int j = 0; j < 4; ++j) { u32x2 w; w.x = pk2(v[k][j][0], v[k][j][1]); w.y = pk2(v[k][j][2], v[k][j][3]); o[lane + 64 * j] = w; } } }
    }
}

__device__ __forceinline__ void dt_phase(const Ctx& a) {
    const int lane = threadIdx.x & 63, fr = lane & 15, fq = lane >> 4, gw = blockIdx.x * 8 + (threadIdx.x >> 6), NGW = gridDim.x * 8;
    const bf16_t* XB = (const bf16_t*)(a.ws + WS_XB); const bf16_t* WIN = (const bf16_t*)(a.ws + WS_WIN);
    const float* rstd = (const float*)(a.ws + WS_RSTD1); const float* bias = a.in(11); float* DT = (float*)(a.ws + WS_DT);
    for (int rb = gw; rb < T / 16; rb += NGW) {
        const bf16_t* ap = XB + (size_t)(16 * rb + fr) * DM + 8 * fq; const bf16_t* bp = WIN + (size_t)(PC_DT + fr) * DM + 8 * fq;
        f32x4 acc0 = {0.f, 0.f, 0.f, 0.f}, acc1 = acc0;
#pragma unroll 1
        for (int k0 = 0; k0 < 32; k0 += 16) {
            bf16x8 av[16], b0[16], b1[16];
#pragma unroll
            for (int kk = 0; kk < 16; ++kk) { av[kk] = *(const bf16x8*)(ap + 32 * (k0 + kk)); b0[kk] = *(const bf16x8*)(bp + 32 * (k0 + kk)); b1[kk] = *(const bf16x8*)(bp + (size_t)16 * DM + 32 * (k0 + kk)); }
#pragma unroll
            for (int kk = 0; kk < 16; ++kk) { acc0 = __builtin_amdgcn_mfma_f32_16x16x32_bf16(av[kk], b0[kk], acc0, 0, 0, 0); acc1 = __builtin_amdgcn_mfma_f32_16x16x32_bf16(av[kk], b1[kk], acc1, 0, 0, 0); }
        }
        const float bc0 = bias[fr], bc1 = bias[16 + fr];
#pragma unroll
        for (int r = 0; r < 4; ++r) { const int row = 16 * rb + 4 * fq + r; const float rs = rstd[row];
            DT[(size_t)row * 32 + fr] = softplusf_(rs * acc0[r] + bc0); DT[(size_t)row * 32 + 16 + fr] = softplusf_(rs * acc1[r] + bc1); }
    }
}
__device__ __forceinline__ void unpack8(const u32x4 w, float (&f)[8]) { f[0] = lo16(w.x); f[1] = hi16(w.x); f[2] = lo16(w.y); f[3] = hi16(w.y); f[4] = lo16(w.z); f[5] = hi16(w.z); f[6] = lo16(w.w); f[7] = hi16(w.w); }
__device__ __forceinline__ u32x4 pack8(const float (&f)[8]) { u32x4 w; w.x = pk2(f[0], f[1]); w.y = pk2(f[2], f[3]); w.z = pk2(f[4], f[5]); w.w = pk2(f[6], f[7]); return w; }
__device__ __forceinline__ void lora_prep(const Ctx& a) {
    const bf16_t* PROJ = (const bf16_t*)(a.ws + WS_PROJ); bf16_t* LA = (bf16_t*)(a.ws + WS_LA);
    const float* mu = a.in(16); const float* sh = a.in(4);
    for (int i = blockIdx.x * 512 + threadIdx.x; i < T * 32; i += gridDim.x * 512) {
        const int row = i >> 5, j = (i & 31) * 8, c = 3072 + j;
        int samp, b, t; rowinfo(row, samp, b, t);
        float raw[8], prev[8], o[8];
        unpack8(*(const u32x4*)(PROJ + (size_t)row * PW + PC_RW + c), raw);
        if (t > 0) unpack8(*(const u32x4*)(PROJ + (size_t)(row - 1) * PW + PC_RW + c), prev);
        else {
#pragma unroll
            for (int k = 0; k < 8; ++k) prev[k] = samp ? sh[(size_t)b * RSD + c + k] : 0.f; }
#pragma unroll
        for (int k = 0; k < 8; ++k) { const float mx = raw[k] + (prev[k] - raw[k]) * mu[c + k]; o[k] = j < 64 ? tanhf(mx) : (j < 128 ? mx : sigmoidf_(mx)); }
        *(u32x4*)(LA + (size_t)row * 256 + j) = pack8(o);
    }
}

__device__ __forceinline__ void conv_load(u32x4 (&u)[11], const bf16_t* PROJ, int o, int cd) {
    const int row0 = 8 * o; const bool samp = row0 >= TP; const int t0 = samp ? 0 : (row0 & 2047);
    const bf16_t* src = PROJ + (size_t)row0 * PW + PC_XBC + cd;
#pragma unroll
    for (int i = 0; i < 3; ++i) { u[i] = (u32x4){0u, 0u, 0u, 0u}; if (t0 > 0) u[i] = *(const u32x4*)(src + (long)(i - 3) * PW); }
#pragma unroll
    for (int i = 3; i < 11; ++i) u[i] = *(const u32x4*)(src + (long)(i - 3) * PW);
}
__device__ __forceinline__ void conv_compute(const u32x4 (&u)[11], int o, int cd, const float (&w)[4][8], const float (&bb)[8], const float* cst, bf16_t* XC, bf16_t* BC) {
    const int row0 = 8 * o; const bool samp = row0 >= TP; const int b = (row0 - TP) >> 3;
    float x[11][8];
#pragma unroll
    for (int i = 0; i < 11; ++i) unpack8(u[i], x[i]);
    if (samp) {
#pragma unroll
        for (int i = 0; i < 3; ++i) { const f32x4 p0 = *(const f32x4*)(cst + (size_t)(b * 3 + i) * CD + cd), p1 = *(const f32x4*)(cst + (size_t)(b * 3 + i) * CD + cd + 4);
#pragma unroll
            for (int j = 0; j < 4; ++j) { x[i][j] = p0[j]; x[i][4 + j] = p1[j]; } }
    }
    bf16_t* dst = cd < 2048 ? XC + (size_t)row0 * 2048 + cd : BC + (size_t)row0 * 1024 + (cd - 2048);
    const int dld = cd < 2048 ? 2048 : 1024;
#pragma unroll
    for (int l = 0; l < 8; ++l) { float o8[8];
#pragma unroll
        for (int j = 0; j < 8; ++j) o8[j] = siluf_(bb[j] + w[0][j] * x[l][j] + w[1][j] * x[l + 1][j] + w[2][j] * x[l + 2][j] + w[3][j] * x[l + 3][j]);
        *(u32x4*)(dst + (size_t)l * dld) = pack8(o8); }
}
__device__ __forceinline__ void conv_prepass(const Ctx& a) {
    const bf16_t* PROJ = (const bf16_t*)(a.ws + WS_PROJ); bf16_t* XC = (bf16_t*)(a.ws + WS_XC); bf16_t* BC = (bf16_t*)(a.ws + WS_BC);
    const float* cw = a.in(9); const float* cbias = a.in(10); const float* cst = a.in(2);
    const int gt = blockIdx.x * 512 + threadIdx.x, NGT = gridDim.x * 512, NCOL = 384, nslab = NGT / NCOL;
    if (gt >= nslab * NCOL) return;
    const int cd = (gt % NCOL) * 8, NO = T / 8;
    float w[4][8], bb[8];
#pragma unroll
    for (int j = 0; j < 4; ++j) { const f32x4 p0 = *(const f32x4*)(cw + j * CD + cd), p1 = *(const f32x4*)(cw + j * CD + cd + 4);
#pragma unroll
        for (int k = 0; k < 4; ++k) { w[j][k] = p0[k]; w[j][4 + k] = p1[k]; } }
    { const f32x4 p0 = *(const f32x4*)(cbias + cd), p1 = *(const f32x4*)(cbias + cd + 4);
#pragma unroll
      for (int k = 0; k < 4; ++k) { bb[k] = p0[k]; bb[4 + k] = p1[k]; } }
    u32x4 uA[11], uB[11];
    int o = gt / NCOL;
    if (o < NO) conv_load(uA, PROJ, o, cd);
    while (o < NO) {
        int o2 = o + nslab;
        if (o2 < NO) conv_load(uB, PROJ, o2, cd);
        conv_compute(uA, o, cd, w, bb, cst, XC, BC);
        o = o2; if (o >= NO) break;
        o2 = o + nslab;
        if (o2 < NO) conv_load(uA, PROJ, o2, cd);
        conv_compute(uB, o, cd, w, bb, cst, XC, BC);
        o = o2;
    }
}

__device__ __forceinline__ void ssd_prompt_unit(const Ctx& a, int b, int head, unsigned char* lds, bool dry) {
    const int tid = threadIdx.x, lane = tid & 63, wave = tid >> 6, fr = lane & 15, fq = lane >> 4, g = head >> 3;
    bf16_t* Cs = (bf16_t*)lds;
    bf16_t* Bs = (bf16_t*)(lds + 17408);
    bf16_t* Hs = (bf16_t*)(lds + 34816);
    bf16_t* BwT = (bf16_t*)(lds + 52224);
    bf16_t* XT = (bf16_t*)(lds + 70656);
    bf16_t* Ps = (bf16_t*)(lds + 79872);
    bf16_t* Zs = (bf16_t*)(lds + 89088);
    bf16_t* Ys = (bf16_t*)(lds + 98304);
    float* csf = (float*)(lds + 107520); float* dtf = (float*)(lds + 107776);
    bf16_t* PROJ = (bf16_t*)(a.ws + WS_PROJ); const bf16_t* XC = (const bf16_t*)(a.ws + WS_XC); const bf16_t* BC = (const bf16_t*)(a.ws + WS_BC);
    const float* DT = (const float*)(a.ws + WS_DT); float* SSA = (float*)(a.ws + WS_SSA);
    const float Aneg = -__expf(a.in(12)[head]), Dh = a.in(13)[head];
    const int ll = tid >> 3, c8 = tid & 7, lb2 = tid >> 4, c16 = tid & 15;
    f32x4 hacc[4];
#pragma unroll
    for (int i = 0; i < 4; ++i) hacc[i] = (f32x4){0.f, 0.f, 0.f, 0.f};
    for (int i = tid; i < 64 * 136 / 2; i += 512) ((unsigned*)Hs)[i] = 0u;
    u32x4 rx, rz, rb0, rb1, rc0, rc1; float rdt = 0.f;
#define SSD_LOAD(c) do { const size_t r0_ = (size_t)b * SEQ + (size_t)(c) * 64; \
        rx = *(const u32x4*)(XC + (r0_ + ll) * 2048 + head * 64 + 8 * c8); rz = *(const u32x4*)(PROJ + (r0_ + ll) * PW + PC_Z + head * 64 + 8 * c8); \
        rb0 = *(const u32x4*)(BC + (r0_ + lb2) * 1024 + g * 128 + 8 * c16); rb1 = *(const u32x4*)(BC + (r0_ + 32 + lb2) * 1024 + g * 128 + 8 * c16); \
        rc0 = *(const u32x4*)(BC + (r0_ + lb2) * 1024 + 512 + g * 128 + 8 * c16); rc1 = *(const u32x4*)(BC + (r0_ + 32 + lb2) * 1024 + 512 + g * 128 + 8 * c16); \
        if (wave == 0) rdt = DT[(r0_ + lane) * 32 + head]; } while (0)
    SSD_LOAD(0);
    for (int c = 0; c < 32; ++c) {
        const int row0 = b * SEQ + c * 64;
        if (wave == 0) { float cs = rdt * Aneg;
#pragma unroll
            for (int o = 1; o < 64; o <<= 1) { const float v = __shfl_up(cs, o); if (lane >= o) cs += v; }
            csf[lane] = cs; dtf[lane] = rdt; }
        { const unsigned xw[4] = {rx.x, rx.y, rx.z, rx.w};
#pragma unroll
          for (int j = 0; j < 4; ++j) { XT[(8 * c8 + 2 * j) * 72 + ll] = (bf16_t)(xw[j] & 0xffffu); XT[(8 * c8 + 2 * j + 1) * 72 + ll] = (bf16_t)(xw[j] >> 16); } }
        *(u32x4*)(Zs + ll * 72 + 8 * c8) = rz;
        *(u32x4*)(Bs + lb2 * 136 + 8 * c16) = rb0; *(u32x4*)(Bs + (32 + lb2) * 136 + 8 * c16) = rb1;
        *(u32x4*)(Cs + lb2 * 136 + 8 * c16) = rc0; *(u32x4*)(Cs + (32 + lb2) * 136 + 8 * c16) = rc1;
        lds_barrier();
        if (c + 1 < 32) SSD_LOAD(c + 1);
        const float cs_last = csf[63];
        {
            const int n = tid & 127, lq = tid >> 7;
            float v[16];
#pragma unroll
            for (int i = 0; i < 16; ++i) { const int l = 16 * lq + i; v[i] = bf2f(Bs[l * 136 + n]) * dtf[l] * __expf(cs_last - csf[l]); }
            u32x4 w; w.x = pk2(v[0], v[1]); w.y = pk2(v[2], v[3]); w.z = pk2(v[4], v[5]); w.w = pk2(v[6], v[7]);
            *(u32x4*)(BwT + n * 72 + 16 * lq) = w;
            w.x = pk2(v[8], v[9]); w.y = pk2(v[10], v[11]); w.z = pk2(v[12], v[13]); w.w = pk2(v[14], v[15]);
            *(u32x4*)(BwT + n * 72 + 16 * lq + 8) = w;
        }
        {
            const int lb = wave >> 1;
#pragma unroll
            for (int j = 0; j < 2; ++j) {
                const int sb = 2 * (wave & 1) + j;
                f32x4 acc = {0.f, 0.f, 0.f, 0.f};
                if (sb <= lb) {
#pragma unroll
                    for (int kk = 0; kk < 4; ++kk) {
                        const bf16x8 av = *(const bf16x8*)(Cs + (16 * lb + fr) * 136 + 32 * kk + 8 * fq);
                        const bf16x8 bv = *(const bf16x8*)(Bs + (16 * sb + fr) * 136 + 32 * kk + 8 * fq);
                        acc = __builtin_amdgcn_mfma_f32_16x16x32_bf16(av, bv, acc, 0, 0, 0);
                    }
                }
                const int s = 16 * sb + fr; const float css = csf[s], dts = dtf[s];
#pragma unroll
                for (int r = 0; r < 4; ++r) { const int l = 16 * lb + 4 * fq + r;
                    const float p = (s <= l) ? acc[r] * __expf(csf[l] - css) * dts : 0.f;
                    Ps[l * 72 + s] = (bf16_t)f2bf(p); }
            }
        }
        lds_barrier();
        {
            const int lb = wave >> 1;
            float ssq[4] = {0.f, 0.f, 0.f, 0.f};
#pragma unroll
            for (int j = 0; j < 2; ++j) {
                const int pb = 2 * (wave & 1) + j;
                f32x4 yd = {0.f, 0.f, 0.f, 0.f}, yo = {0.f, 0.f, 0.f, 0.f};
#pragma unroll
                for (int kk = 0; kk < 2; ++kk) {
                    const bf16x8 av = *(const bf16x8*)(Ps + (16 * lb + fr) * 72 + 32 * kk + 8 * fq);
                    const bf16x8 bv = *(const bf16x8*)(XT + (16 * pb + fr) * 72 + 32 * kk + 8 * fq);
                    yd = __builtin_amdgcn_mfma_f32_16x16x32_bf16(av, bv, yd, 0, 0, 0);
                }
                if (c > 0) {
#pragma unroll
                    for (int kk = 0; kk < 4; ++kk) {
                        const bf16x8 av = *(const bf16x8*)(Cs + (16 * lb + fr) * 136 + 32 * kk + 8 * fq);
                        const bf16x8 bv = *(const bf16x8*)(Hs + (16 * pb + fr) * 136 + 32 * kk + 8 * fq);
                        yo = __builtin_amdgcn_mfma_f32_16x16x32_bf16(av, bv, yo, 0, 0, 0);
                    }
                }
                const int p = 16 * pb + fr;
#pragma unroll
                for (int r = 0; r < 4; ++r) { const int l = 16 * lb + 4 * fq + r;
                    const float x = bf2f(XT[p * 72 + l]);
                    const float y = yd[r] + yo[r] * __expf(csf[l]) + Dh * x;
                    const bf16_t zo = Zs[l * 72 + p]; const float yz = y * bf2f(zo);
                    Ys[l * 72 + p] = dry ? zo : (bf16_t)f2bf(yz); ssq[r] += yz * yz; }
            }
#pragma unroll
            for (int r = 0; r < 4; ++r) { float s = ssq[r]; s += dppf<0xB1>(s); s += dppf<0x4E>(s); s += dppf<0x141>(s); s += dppf<0x140>(s);
                if (fr == 0) atomicAdd(SSA + (size_t)(row0 + 16 * lb + 4 * fq + r) * 4 + g, dry ? 0.f : s); }
        }
        {
            const float dec = __expf(cs_last);
#pragma unroll
            for (int pb = 0; pb < 4; ++pb) {
                hacc[pb] = hacc[pb] * dec;
#pragma unroll
                for (int kk = 0; kk < 2; ++kk) {
                    const bf16x8 av = *(const bf16x8*)(XT + (16 * pb + fr) * 72 + 32 * kk + 8 * fq);
                    const bf16x8 bv = *(const bf16x8*)(BwT + (16 * wave + fr) * 72 + 32 * kk + 8 * fq);
                    hacc[pb] = __builtin_amdgcn_mfma_f32_16x16x32_bf16(av, bv, hacc[pb], 0, 0, 0);
                }
            }
        }
        lds_barrier();
#pragma unroll
        for (int pb = 0; pb < 4; ++pb)
#pragma unroll
            for (int r = 0; r < 4; ++r) Hs[(16 * pb + 4 * fq + r) * 136 + 16 * wave + fr] = (bf16_t)f2bf(hacc[pb][r]);
        *(u32x4*)(PROJ + (size_t)(row0 + ll) * PW + PC_Z + head * 64 + 8 * c8) = *(const u32x4*)(Ys + ll * 72 + 8 * c8);
    }
#undef SSD_LOAD
    float* so = a.out + O_SSMP + (size_t)(b * NH + head) * 64 * NS;
#pragma unroll
    for (int pb = 0; pb < 4; ++pb)
#pragma unroll
        for (int r = 0; r < 4; ++r) so[(16 * pb + 4 * fq + r) * NS + 16 * wave + fr] = hacc[pb][r];
    __syncthreads();
}

__device__ __forceinline__ void ssd_sample_unit(const Ctx& a, int b, int g, unsigned char* lds, bool dry) {
    const int tid = threadIdx.x;
    float* xs = (float*)lds;
    float* Bsm = (float*)(lds + 16384);
    float* Csm = (float*)(lds + 20480);
    float* dts = (float*)(lds + 24576);
    float* css = (float*)(lds + 24832);
    float* cbs = (float*)(lds + 25088);
    float* ssq = (float*)(lds + 25344);
    bf16_t* PROJ = (bf16_t*)(a.ws + WS_PROJ); const bf16_t* XC = (const bf16_t*)(a.ws + WS_XC); const bf16_t* BC = (const bf16_t*)(a.ws + WS_BC);
    const float* DT = (const float*)(a.ws + WS_DT);
    const int row0 = TP + b * 8;
    const int p = tid >> 3, nq = tid & 7;
    const float* hbase = a.in(3) + ((size_t)(b * NH + g * 8) * 64 + p) * NS + 16 * nq;
    f32x4 hq[4];
#pragma unroll
    for (int j = 0; j < 4; ++j) hq[j] = ((const f32x4*)hbase)[j];
#pragma unroll
    for (int l = 0; l < 8; ++l) xs[l * 512 + tid] = bf2f(XC[(size_t)(row0 + l) * 2048 + g * 512 + tid]);
    if (tid < 256) { const int which = tid >> 7, n = tid & 127; float* dst = which ? Csm : Bsm;
#pragma unroll
        for (int l = 0; l < 8; ++l) dst[l * 128 + n] = bf2f(BC[(size_t)(row0 + l) * 1024 + which * 512 + g * 128 + n]); }
    if (tid < 64) dts[tid] = DT[(size_t)(row0 + (tid >> 3)) * 32 + g * 8 + (tid & 7)];
    if (tid < 8) ssq[tid] = 0.f;
    __syncthreads();
    if (tid < 8) { const float An = -__expf(a.in(12)[g * 8 + tid]); float c = 0.f;
#pragma unroll
        for (int l = 0; l < 8; ++l) { c += dts[l * 8 + tid] * An; css[l * 8 + tid] = c; } }
    { const int pr = tid >> 3, l = pr >> 3, s = pr & 7; float d = 0.f;
#pragma unroll
        for (int j = 0; j < 16; ++j) d += Csm[l * 128 + 16 * nq + j] * Bsm[s * 128 + 16 * nq + j];
        d = sum8(d); if (nq == 0) cbs[l * 8 + s] = d; }
    __syncthreads();
    for (int hh = 0; hh < 8; ++hh) {
        const int head = g * 8 + hh;
        float h0[16];
#pragma unroll
        for (int j = 0; j < 4; ++j) { h0[4 * j] = hq[j][0]; h0[4 * j + 1] = hq[j][1]; h0[4 * j + 2] = hq[j][2]; h0[4 * j + 3] = hq[j][3]; }
        if (hh + 1 < 8) {
#pragma unroll
            for (int j = 0; j < 4; ++j) hq[j] = ((const f32x4*)(hbase + (size_t)(hh + 1) * 64 * NS))[j];
        }
        float csl[8], xl[8], dl[8];
#pragma unroll
        for (int l = 0; l < 8; ++l) { csl[l] = css[l * 8 + hh]; xl[l] = xs[l * 512 + hh * 64 + p]; dl[l] = dts[l * 8 + hh]; }
        float yoff[8];
#pragma unroll
        for (int l = 0; l < 8; ++l) { float s = 0.f;
#pragma unroll
            for (int j = 0; j < 16; ++j) s += Csm[l * 128 + 16 * nq + j] * h0[j];
            yoff[l] = sum8(s); }
        const float dec = __expf(csl[7]);
        float hn[16];
#pragma unroll
        for (int j = 0; j < 16; ++j) hn[j] = h0[j] * dec;
#pragma unroll
        for (int l = 0; l < 8; ++l) { const float w = xl[l] * dl[l] * __expf(csl[7] - csl[l]);
#pragma unroll
            for (int j = 0; j < 16; ++j) hn[j] += Bsm[l * 128 + 16 * nq + j] * w; }
        float* ho = a.out + O_SSMS + ((size_t)(b * NH + head) * 64 + p) * NS + 16 * nq;
#pragma unroll
        for (int j = 0; j < 4; ++j) ((f32x4*)ho)[j] = (f32x4){hn[4 * j], hn[4 * j + 1], hn[4 * j + 2], hn[4 * j + 3]};
        float yo = 0.f, cl = 0.f, xme = 0.f;
#pragma unroll
        for (int l = 0; l < 8; ++l) { if (nq == l) { yo = yoff[l]; cl = csl[l]; xme = xl[l]; } }
        float y = yo * __expf(cl) + a.in(13)[head] * xme;
#pragma unroll
        for (int s = 0; s < 8; ++s) { if (s <= nq) y += cbs[nq * 8 + s] * __expf(cl - csl[s]) * dl[s] * xl[s]; }
        bf16_t* zp = PROJ + (size_t)(row0 + nq) * PW + PC_Z + head * 64 + p;
        const bf16_t zo = *zp; const float yz = y * bf2f(zo);
        *zp = dry ? zo : (bf16_t)f2bf(yz);
        atomicAdd(ssq + nq, yz * yz);
    }
    __syncthreads();
    if (tid < 8) atomicAdd((float*)(a.ws + WS_SSA) + (size_t)(row0 + tid) * 4 + g, dry ? 0.f : ssq[tid]);
    __syncthreads();
}

__device__ __forceinline__ void ya_norm(const Ctx& a, bool dry, int gt0, int NGT) {
    bf16_t* PROJ = (bf16_t*)(a.ws + WS_PROJ); const float* SSA = (const float*)(a.ws + WS_SSA); const float* ng = a.in(14);
    for (int i0 = gt0; i0 < T * 256; i0 += 4 * NGT) {
        u32x4 w[4]; float rs[4];
#pragma unroll
        for (int k = 0; k < 4; ++k) { const int i = i0 + k * NGT; if (i < T * 256) { const int row = i >> 8, c = (i & 255) * 8;
            w[k] = *(const u32x4*)(PROJ + (size_t)row * PW + c); rs[k] = SSA[(size_t)row * 4 + (c >> 9)]; } }
#pragma unroll
        for (int k = 0; k < 4; ++k) { const int i = i0 + k * NGT; if (i < T * 256) { const int row = i >> 8, c = (i & 255) * 8;
            const float r = rsqrtf(rs[k] * (1.f / 512.f) + NORM_EPS);
            float f[8]; unpack8(w[k], f);
            const f32x4 g0 = *(const f32x4*)(ng + c), g1 = *(const f32x4*)(ng + c + 4);
#pragma unroll
            for (int j = 0; j < 4; ++j) { f[j] *= r * g0[j]; f[4 + j] *= r * g1[j]; }
            *(u32x4*)(PROJ + (size_t)row * PW + c) = dry ? w[k] : pack8(f); } }
    }
}

constexpr int RW_TB = 32, RW_STEPF = 388;
typedef float f32x2 __attribute__((ext_vector_type(2)));
struct RwConst { float mu_r, mu_k, mu_v, kk_w, ka_w, rk_w; };
__device__ __forceinline__ void rwkv_scalars(const Ctx& a) {
    bf16_t* PROJ = (bf16_t*)(a.ws + WS_PROJ); const bf16_t* LOA = (const bf16_t*)(a.ws + WS_LOA); float* RWS = (float*)(a.ws + WS_RWS);
    const int lane = threadIdx.x & 63, gw = blockIdx.x * 8 + (threadIdx.x >> 6), NGW = gridDim.x * 8;
    const float* sh = a.in(4);
    for (int item = gw; item < 2048; item += NGW) {
        const int half = item & 1, rbeg = (item >> 1) * 17, c0 = half * 512 + lane * 8, head = half * 8 + (lane >> 3);
        float mur[8], muk[8], muv[8], kkw[8], kaw[8], rkw[8];
#pragma unroll
        for (int j = 0; j < 2; ++j) {
            const f32x4 t0 = *(const f32x4*)(a.in(16) + c0 + 4 * j), t1 = *(const f32x4*)(a.in(16) + 1024 + c0 + 4 * j), t2 = *(const f32x4*)(a.in(16) + 2048 + c0 + 4 * j);
            const f32x4 t3 = *(const f32x4*)(a.in(22) + c0 + 4 * j), t4 = *(const f32x4*)(a.in(23) + c0 + 4 * j), t5 = *(const f32x4*)(a.in(24) + c0 + 4 * j);
#pragma unroll
            for (int k = 0; k < 4; ++k) { mur[4 * j + k] = t0[k]; muk[4 * j + k] = t1[k]; muv[4 * j + k] = t2[k]; kkw[4 * j + k] = t3[k]; kaw[4 * j + k] = t4[k]; rkw[4 * j + k] = t5[k]; }
        }
        const bf16_t* pr = PROJ + (size_t)rbeg * PW + PC_RW + c0;
        u32x4 pR = {0u, 0u, 0u, 0u}, pK = pR, pV = pR;
        if (rbeg > 0) { pR = *(const u32x4*)(pr - (long)PW); pK = *(const u32x4*)(pr + 1024 - (long)PW); pV = *(const u32x4*)(pr + 2048 - (long)PW); }
        u32x4 cR = *(const u32x4*)pr, cK = *(const u32x4*)(pr + 1024), cV = *(const u32x4*)(pr + 2048), cA = *(const u32x4*)(LOA + (size_t)rbeg * 1024 + c0);
        for (int i = 0; i < 17; ++i) {
            const int row = rbeg + i;
            u32x4 nR = cR, nK = cK, nV = cV, nA = cA;
            if (i + 1 < 17) { const bf16_t* pn = pr + (size_t)(i + 1) * PW; nR = *(const u32x4*)pn; nK = *(const u32x4*)(pn + 1024); nV = *(const u32x4*)(pn + 2048); nA = *(const u32x4*)(LOA + (size_t)(row + 1) * 1024 + c0); }
            int samp, b, t; rowinfo(row, samp, b, t);
            float rr[8], rk[8], rv[8], qr[8], qk[8], qv[8], av[8], vx[8];
            unpack8(cR, rr); unpack8(cK, rk); unpack8(cV, rv); unpack8(cA, av);
            if (t > 0) { unpack8(pR, qr); unpack8(pK, qk); unpack8(pV, qv); }
            else {
#pragma unroll
                for (int j = 0; j < 8; ++j) { const int c = c0 + j; qr[j] = samp ? sh[(size_t)b * RSD + c] : 0.f; qk[j] = samp ? sh[(size_t)b * RSD + 1024 + c] : 0.f; qv[j] = samp ? sh[(size_t)b * RSD + 2048 + c] : 0.f; } }
            float n2 = 0.f, brs = 0.f, krs = 0.f, bon = 0.f;
#pragma unroll
            for (int j = 0; j < 8; ++j) {
                const float r = rr[j] + (qr[j] - rr[j]) * mur[j], kx = rk[j] + (qk[j] - rk[j]) * muk[j]; vx[j] = rv[j] + (qv[j] - rv[j]) * muv[j];
                const float kkr = kx * kkw[j], kp = kx * (1.f + (av[j] - 1.f) * kaw[j]);
                n2 += kkr * kkr; brs += kkr * av[j] * r; krs += kp * r; bon += r * kp * rkw[j]; }
            n2 = sum8(n2); brs = sum8(brs); krs = sum8(krs); bon = sum8(bon);
            const float inv = 1.f / fmaxf(sqrtf(n2), 1e-12f);
            if ((lane & 7) == 0) *(f32x4*)(RWS + ((size_t)row * 16 + head) * 4) = (f32x4){inv, brs * inv, krs, bon};
            float o[8];
#pragma unroll
            for (int j = 0; j < 8; ++j) o[j] = bon * vx[j];
            *(u32x4*)(PROJ + (size_t)row * PW + PC_BV + c0) = pack8(o);
            pR = cR; pK = cK; pV = cV; cR = nR; cK = nK; cV = nV; cA = nA;
        }
    }
}
template <int NS, int NPRE> struct RwPrep { float rr[NS], rk[NS], rv[NS], le[NS], la[NS], lp[NPRE]; f32x4 sc[NS]; float q0r, q0k, q0v; int npre; };
template <int NS, int NPRE>
__device__ __forceinline__ void rwkv_prep_load(RwPrep<NS, NPRE>& P, const bf16_t* PROJ, const bf16_t* LOE, const bf16_t* LOA, const float* RWS, int row0, int tblock, int tfirst, int h, int lane, const float* shiftprev) {
    const int cr = h * 64 + lane;
    {
        const bf16_t* pr = PROJ + (size_t)(row0 + tfirst) * PW + PC_RW + cr;
        if (tfirst > 0) { P.q0r = bf2f(pr[-(long)PW]); P.q0k = bf2f(pr[1024 - (long)PW]); P.q0v = bf2f(pr[2048 - (long)PW]); }
        else if (shiftprev) { P.q0r = shiftprev[cr]; P.q0k = shiftprev[1024 + cr]; P.q0v = shiftprev[2048 + cr]; }
        else { P.q0r = 0.f; P.q0k = 0.f; P.q0v = 0.f; }
    }
    P.npre = tfirst - tblock;
#pragma unroll
    for (int j = 0; j < NPRE; ++j) { const int jj = j < P.npre ? j : 0; P.lp[j] = bf2f(LOE[(size_t)(row0 + tblock + jj) * 1024 + cr]); }
#pragma unroll
    for (int i = 0; i < NS; ++i) {
        const size_t row = (size_t)(row0 + tfirst + i);
        const bf16_t* pr = PROJ + row * PW + PC_RW + cr;
        P.rr[i] = bf2f(pr[0]); P.rk[i] = bf2f(pr[1024]); P.rv[i] = bf2f(pr[2048]);
        P.le[i] = bf2f(LOE[row * 1024 + cr]); P.la[i] = bf2f(LOA[row * 1024 + cr]);
        P.sc[i] = *(const f32x4*)(RWS + (row * 16 + h) * 4);
    }
}
template <int NS, int NPRE>
__device__ __forceinline__ void rwkv_prep_compute(const RwPrep<NS, NPRE>& P, float* slot0, int lane, const RwConst& K) {
    float esum = 0.f;
#pragma unroll
    for (int j = 0; j < NPRE; ++j) esum += (j < P.npre) ? P.lp[j] : 0.f;
    float Wprev = __expf(-esum);
#pragma unroll
    for (int i = 0; i < NS; ++i) {
        const float qr = i ? P.rr[i ? i - 1 : 0] : P.q0r, qk = i ? P.rk[i ? i - 1 : 0] : P.q0k, qv = i ? P.rv[i ? i - 1 : 0] : P.q0v;
        const float r = P.rr[i] + (qr - P.rr[i]) * K.mu_r, kx = P.rk[i] + (qk - P.rk[i]) * K.mu_k, vx = P.rv[i] + (qv - P.rv[i]) * K.mu_v;
        const float Wt = Wprev * __expf(-P.le[i]), inv = 1.f / Wt, av = P.la[i];
        const float kk = kx * K.kk_w * P.sc[i][0];
        const float kp = kx * (1.f + (av - 1.f) * K.ka_w), bb = kk * av;
        float* d = slot0 + (size_t)i * RW_STEPF;
        d[lane] = -kk * Wprev; d[64 + lane] = Wt * r; d[128 + lane] = Wt; d[192 + lane] = bb * inv; d[256 + lane] = kp * inv; d[320 + lane] = vx;
        if (lane == 0) { d[384] = P.sc[i][1]; d[385] = P.sc[i][2]; }
        Wprev = Wt;
    }
}
struct RwStep { f32x4 n, r, b, k; f32x2 vv, sc; };
__device__ __forceinline__ void rw_load(RwStep& R, const float* d, int q, int v0) {
    R.n = *(const f32x4*)(d + 4 * q); R.r = *(const f32x4*)(d + 64 + 4 * q);
    R.b = *(const f32x4*)(d + 192 + 4 * q); R.k = *(const f32x4*)(d + 256 + 4 * q);
    R.vv = *(const f32x2*)(d + 320 + v0); R.sc = *(const f32x2*)(d + 384);
}
#define LOH(x) __builtin_shufflevector(x, x, 0, 1)
#define HIH(x) __builtin_shufflevector(x, x, 2, 3)
__device__ __forceinline__ float sum16(float v) { v += dppf<0xB1>(v); v += dppf<0x4E>(v); v += dppf<0x141>(v); v += dppf<0x140>(v); return v; }
template <int VAR = 0> __device__ __forceinline__ void rw_step(f32x2 (&s)[2][2], const RwStep& c, int q, bf16_t* yo) {
    f32x2 a0 = s[0][0] * LOH(c.n), a1 = s[1][0] * LOH(c.n), e0 = s[0][0] * LOH(c.r), e1 = s[1][0] * LOH(c.r);
    a0 = s[0][1] * HIH(c.n) + a0; a1 = s[1][1] * HIH(c.n) + a1; e0 = s[0][1] * HIH(c.r) + e0; e1 = s[1][1] * HIH(c.r) + e1;
    float sa0 = a0.x + a0.y, sa1 = a1.x + a1.y, y20 = e0.x + e0.y, y21 = e1.x + e1.y;
    if (VAR != 1) { sa0 = sum16(sa0); sa1 = sum16(sa1); y20 = sum16(y20); y21 = sum16(y21); }
    const float y0 = y20 + sa0 * c.sc.x + c.vv.x * c.sc.y, y1 = y21 + sa1 * c.sc.x + c.vv.y * c.sc.y;
    const f32x2 s0v = {sa0, sa0}, s1v = {sa1, sa1}, v0v = {c.vv.x, c.vv.x}, v1v = {c.vv.y, c.vv.y};
    s[0][0] = s0v * LOH(c.b) + (v0v * LOH(c.k) + s[0][0]);
    s[0][1] = s0v * HIH(c.b) + (v0v * HIH(c.k) + s[0][1]);
    s[1][0] = s1v * LOH(c.b) + (v1v * LOH(c.k) + s[1][0]);
    s[1][1] = s1v * HIH(c.b) + (v1v * HIH(c.k) + s[1][1]);
    if (q == 0) *(unsigned*)yo = pk2(y0, y1);
}
template <int VAR = 0> __device__ __forceinline__ void rwkv_scan_block(f32x2 (&s)[2][2], const float* stp, int nb, int q, int v0, bf16_t* yo) {
    RwStep c0, c1; rw_load(c0, stp, q, v0);
    if (VAR == 5) {
        c1 = c0;
        for (int tt = 0; tt < nb; tt += 2) { rw_step<0>(s, c0, q, yo + (size_t)tt * PW); rw_step<0>(s, c1, q, yo + (size_t)(tt + 1) * PW); }
    } else if (VAR == 6) {
        f32x4 accv = {0.f, 0.f, 0.f, 0.f};
        for (int tt = 0; tt < nb; tt += 2) {
            rw_load(c1, stp + (size_t)(tt + 1) * RW_STEPF, q, v0); accv = accv + c0.n + c0.r + c0.b + c0.k;
            rw_load(c0, stp + (size_t)((tt + 2 < nb) ? tt + 2 : tt) * RW_STEPF, q, v0); accv = accv + c1.n + c1.r + c1.b + c1.k;
        }
        s[0][0] = LOH(accv); s[0][1] = HIH(accv);
    } else
    for (int tt = 0; tt < nb; tt += 2) {
        rw_load(c1, stp + (size_t)(tt + 1) * RW_STEPF, q, v0);
        rw_step<VAR>(s, c0, q, yo + (size_t)tt * PW);
        rw_load(c0, stp + (size_t)((tt + 2 < nb) ? tt + 2 : tt) * RW_STEPF, q, v0);
        rw_step<VAR>(s, c1, q, yo + (size_t)(tt + 1) * PW);
    }
    const f32x4 wend = *(const f32x4*)(stp + (size_t)(nb - 1) * RW_STEPF + 128 + 4 * q);
#pragma unroll
    for (int i = 0; i < 2; ++i) { s[i][0] = s[i][0] * LOH(wend); s[i][1] = s[i][1] * HIH(wend); }
}
__device__ __forceinline__ void rw_state_load(f32x2 (&s)[2][2], const float* S0, int v0, int q) {
#pragma unroll
    for (int i = 0; i < 2; ++i) { const f32x4 t = *(const f32x4*)(S0 + (v0 + i) * 64 + 4 * q); s[i][0] = LOH(t); s[i][1] = HIH(t); }
}
__device__ __forceinline__ void rw_state_store(const f32x2 (&s)[2][2], float* So, int v0, int q) {
#pragma unroll
    for (int i = 0; i < 2; ++i) *(f32x4*)(So + (v0 + i) * 64 + 4 * q) = (f32x4){s[i][0].x, s[i][0].y, s[i][1].x, s[i][1].y};
}
__device__ __forceinline__ RwConst rw_consts(const Ctx& a, int cr) {
    RwConst K; K.mu_r = a.in(16)[cr]; K.mu_k = a.in(16)[1024 + cr]; K.mu_v = a.in(16)[2048 + cr]; K.kk_w = a.in(22)[cr]; K.ka_w = a.in(23)[cr]; K.rk_w = a.in(24)[cr]; return K;
}
__device__ __forceinline__ void rwkv_sample_unit(const Ctx& a, int u, unsigned char* lds) {
    const int tid = threadIdx.x, lane = tid & 63, wave = tid >> 6, b = u >> 4, h = u & 15, cr = h * 64 + lane;
    float* stp = (float*)lds; bf16_t* PROJ = (bf16_t*)(a.ws + WS_PROJ);
    const int row0 = TP + b * 8, v = wave * 8 + 2 * (lane >> 4), q = lane & 15;
    f32x2 s[2][2]; rw_state_load(s, a.in(5) + (size_t)u * 4096, v, q);
    const RwConst K = rw_consts(a, cr);
    { RwPrep<1, 7> P; rwkv_prep_load<1, 7>(P, PROJ, (const bf16_t*)(a.ws + WS_LOE), (const bf16_t*)(a.ws + WS_LOA), (const float*)(a.ws + WS_RWS), row0, 0, wave, h, lane, a.in(4) + (size_t)b * RSD);
      rwkv_prep_compute<1, 7>(P, stp + wave * RW_STEPF, lane, K); }
    __syncthreads();
    rwkv_scan_block(s, stp, 8, q, v, PROJ + (size_t)row0 * PW + PC_YB + h * 64 + v);
    rw_state_store(s, a.out + O_RWKVS + (size_t)u * 4096, v, q);
    __syncthreads();
}
struct RwStep1 { f32x4 n, r, w, b, k; float vv; f32x2 sc; };
__device__ __forceinline__ void rw_load1(RwStep1& R, const float* d, int q, int v) {
    R.n = *(const f32x4*)(d + 4 * q); R.r = *(const f32x4*)(d + 64 + 4 * q); R.w = *(const f32x4*)(d + 128 + 4 * q);
    R.b = *(const f32x4*)(d + 192 + 4 * q); R.k = *(const f32x4*)(d + 256 + 4 * q);
    R.vv = d[320 + v]; R.sc = *(const f32x2*)(d + 384);
}
__device__ __forceinline__ void rw_step1(f32x2 (&s)[2], const RwStep1& c, int q, bf16_t* yo) {
    f32x2 a0 = s[0] * LOH(c.n), e0 = s[0] * LOH(c.r);
    a0 = s[1] * HIH(c.n) + a0; e0 = s[1] * HIH(c.r) + e0;
    const float sa = sum16(a0.x + a0.y), y2 = sum16(e0.x + e0.y);
    const float y = y2 + sa * c.sc.x + c.vv * c.sc.y;
    const f32x2 sav = {sa, sa}, vvv = {c.vv, c.vv};
    s[0] = s[0] * LOH(c.w) + (sav * LOH(c.b) + vvv * LOH(c.k));
    s[1] = s[1] * HIH(c.w) + (sav * HIH(c.b) + vvv * HIH(c.k));
    if (q == 0) *yo = (bf16_t)f2bf(y);
}
template <int VAR = 0> __device__ __forceinline__ void rwkv_prompt_unit(const Ctx& a, int u, unsigned char* lds) {
    const int tid = threadIdx.x, lane = tid & 63, wave = tid >> 6, bh = u >> 1, half = u & 1, b = bh >> 4, h = bh & 15, cr = h * 64 + lane;
    float* buf = (float*)lds; bf16_t* PROJ = (bf16_t*)(a.ws + WS_PROJ);
    const bf16_t* LOE = (const bf16_t*)(a.ws + WS_LOE); const bf16_t* LOA = (const bf16_t*)(a.ws + WS_LOA);
    const int row0 = b * SEQ, v = half * 32 + (wave & 3) * 8 + 2 * (lane >> 4), q = lane & 15, pw = wave - 4;
    constexpr int NBLK = SEQ / RW_TB, BUFF = RW_TB * RW_STEPF;
    f32x2 s[2][2] = {{{0.f, 0.f}, {0.f, 0.f}}, {{0.f, 0.f}, {0.f, 0.f}}};
    const RwConst K = rw_consts(a, cr);
    const float* RWS = (const float*)(a.ws + WS_RWS);
    RwPrep<8, 24> P;
    if (wave >= 4) { rwkv_prep_load<8, 24>(P, PROJ, LOE, LOA, RWS, row0, 0, 8 * pw, h, lane, nullptr); rwkv_prep_compute<8, 24>(P, buf + 8 * pw * RW_STEPF, lane, K);
        rwkv_prep_load<8, 24>(P, PROJ, LOE, LOA, RWS, row0, RW_TB, RW_TB + 8 * pw, h, lane, nullptr); }
    else __builtin_amdgcn_s_setprio(2);
    lds_barrier();
    for (int blk = 0; blk < NBLK; ++blk) {
        if (wave < 4) { if (VAR != 2) rwkv_scan_block<VAR>(s, buf + (blk & 1) * BUFF, RW_TB, q, v, PROJ + (size_t)(row0 + blk * RW_TB) * PW + PC_YB + h * 64 + v); }
        else if (blk + 1 < NBLK && VAR != 3) { rwkv_prep_compute<8, 24>(P, buf + ((blk + 1) & 1) * BUFF + 8 * pw * RW_STEPF, lane, K);
            if (blk + 2 < NBLK) rwkv_prep_load<8, 24>(P, PROJ, LOE, LOA, RWS, row0, (blk + 2) * RW_TB, (blk + 2) * RW_TB + 8 * pw, h, lane, nullptr); }
        lds_barrier();
    }
    __builtin_amdgcn_s_setprio(0);
    __syncthreads();
    if (wave < 4) rw_state_store(s, a.out + O_RWKVP + (size_t)bh * 4096, v, q);
}
__device__ __forceinline__ void rwkv_post(const Ctx& a, bool dry, int gw, int NGW) {
    bf16_t* PROJ = (bf16_t*)(a.ws + WS_PROJ); const bf16_t* LOG = (const bf16_t*)(a.ws + WS_LOG);
    const int lane = threadIdx.x & 63, c0 = lane * 16;
    float lw[16], lb[16];
#pragma unroll
    for (int j = 0; j < 4; ++j) { const f32x4 x = *(const f32x4*)(a.in(25) + c0 + 4 * j), y = *(const f32x4*)(a.in(26) + c0 + 4 * j);
#pragma unroll
        for (int k = 0; k < 4; ++k) { lw[4 * j + k] = x[k]; lb[4 * j + k] = y[k]; } }
    for (int r0 = gw; r0 < T; r0 += 2 * NGW) {
        u32x4 yw[2][2], bw[2][2], gw4[2][2];
#pragma unroll
        for (int k = 0; k < 2; ++k) { const int row = r0 + k * NGW; if (row < T) {
            const bf16_t* yp = PROJ + (size_t)row * PW + PC_YB + c0; const bf16_t* bp = PROJ + (size_t)row * PW + PC_BV + c0; const bf16_t* gp = LOG + (size_t)row * 1024 + c0;
            yw[k][0] = *(const u32x4*)yp; yw[k][1] = *(const u32x4*)(yp + 8); bw[k][0] = *(const u32x4*)bp; bw[k][1] = *(const u32x4*)(bp + 8); gw4[k][0] = *(const u32x4*)gp; gw4[k][1] = *(const u32x4*)(gp + 8); } }
#pragma unroll
        for (int k = 0; k < 2; ++k) { const int row = r0 + k * NGW; if (row < T) {
            float y[16], bv[16], gg[16];
            { float t8[8]; unpack8(yw[k][0], t8);
#pragma unroll
              for (int j = 0; j < 8; ++j) y[j] = t8[j];
              unpack8(yw[k][1], t8);
#pragma unroll
              for (int j = 0; j < 8; ++j) y[8 + j] = t8[j];
              unpack8(bw[k][0], t8);
#pragma unroll
              for (int j = 0; j < 8; ++j) bv[j] = t8[j];
              unpack8(bw[k][1], t8);
#pragma unroll
              for (int j = 0; j < 8; ++j) bv[8 + j] = t8[j];
              unpack8(gw4[k][0], t8);
#pragma unroll
              for (int j = 0; j < 8; ++j) gg[j] = t8[j];
              unpack8(gw4[k][1], t8);
#pragma unroll
              for (int j = 0; j < 8; ++j) gg[8 + j] = t8[j]; }
            float sm = 0.f;
#pragma unroll
            for (int j = 0; j < 16; ++j) sm += y[j];
            sm += dppf<0xB1>(sm); sm += dppf<0x4E>(sm);
            const float mean = sm * (1.f / 64.f); float sv = 0.f;
#pragma unroll
            for (int j = 0; j < 16; ++j) { const float d = y[j] - mean; sv += d * d; }
            sv += dppf<0xB1>(sv); sv += dppf<0x4E>(sv);
            const float rstd = rsqrtf(sv * (1.f / 64.f) + GN_EPS);
            float o[16];
#pragma unroll
            for (int j = 0; j < 16; ++j) o[j] = ((y[j] - mean) * rstd * lw[j] + lb[j] + bv[j]) * gg[j];
            bf16_t* yp = PROJ + (size_t)row * PW + PC_YB + c0;
            u32x4 o0, o1; o0.x = pk2(o[0], o[1]); o0.y = pk2(o[2], o[3]); o0.z = pk2(o[4], o[5]); o0.w = pk2(o[6], o[7]); o1.x = pk2(o[8], o[9]); o1.y = pk2(o[10], o[11]); o1.z = pk2(o[12], o[13]); o1.w = pk2(o[14], o[15]);
            *(u32x4*)yp = dry ? yw[k][0] : o0; *(u32x4*)(yp + 8) = dry ? yw[k][1] : o1; } }
    }
}

__device__ __forceinline__ void glu_load(u32x4 (&g)[6], u32x4 (&v)[4], const bf16_t* UP, int rq, int c) {
    const int row = 4 * rq; int samp, b, t; rowinfo(row, samp, b, t);
#pragma unroll
    for (int k = 0; k < 4; ++k) { g[2 + k] = *(const u32x4*)(UP + (size_t)(row + k) * 5632 + c); v[k] = *(const u32x4*)(UP + (size_t)(row + k) * 5632 + DFF + c); }
    g[0] = (u32x4){0u, 0u, 0u, 0u}; g[1] = g[0];
    if (t >= 2) { g[0] = *(const u32x4*)(UP + (size_t)(row - 2) * 5632 + c); g[1] = *(const u32x4*)(UP + (size_t)(row - 1) * 5632 + c); }
}
__device__ __forceinline__ void glu_compute(const u32x4 (&g)[6], const u32x4 (&v)[4], int rq, int c, const float (&w)[3][8], const float (&bb)[8], const float* st, bf16_t* ACT) {
    const int row = 4 * rq; int samp, b, t; rowinfo(row, samp, b, t);
    float ug[6][8];
#pragma unroll
    for (int k = 0; k < 6; ++k) unpack8(g[k], ug[k]);
    if (samp && t < 2) {
#pragma unroll
        for (int i = 0; i < 2; ++i) { const f32x4 p0 = *(const f32x4*)(st + (size_t)(b * 2 + i) * DFF + c), p1 = *(const f32x4*)(st + (size_t)(b * 2 + i) * DFF + c + 4);
#pragma unroll
            for (int j = 0; j < 4; ++j) { ug[i][j] = p0[j]; ug[i][4 + j] = p1[j]; } }
    }
#pragma unroll
    for (int k = 0; k < 4; ++k) { float uv[8], o[8]; unpack8(v[k], uv);
#pragma unroll
        for (int j = 0; j < 8; ++j) { const float gte = bb[j] + w[0][j] * ug[k][j] + w[1][j] * ug[k + 1][j] + w[2][j] * ug[k + 2][j]; o[j] = siluf_(gte) * uv[j]; }
        *(u32x4*)(ACT + (size_t)(row + k) * DFF + c) = pack8(o); }
}
__device__ __forceinline__ void glu_phase(const Ctx& a) {
    const bf16_t* UP = (const bf16_t*)(a.ws + WS_UP); bf16_t* ACT = (bf16_t*)(a.ws + WS_ACT);
    const float* cw = a.in(31); const float* cb = a.in(32); const float* st = a.in(6);
    const int gt = blockIdx.x * 512 + threadIdx.x, NGT = gridDim.x * 512, NCOL = 352, nslab = NGT / NCOL;
    if (gt >= nslab * NCOL) return;
    const int c = (gt % NCOL) * 8, NQ = T / 4;
    float w[3][8], bb[8];
#pragma unroll
    for (int j = 0; j < 3; ++j) { const f32x4 p0 = *(const f32x4*)(cw + j * DFF + c), p1 = *(const f32x4*)(cw + j * DFF + c + 4);
#pragma unroll
        for (int k = 0; k < 4; ++k) { w[j][k] = p0[k]; w[j][4 + k] = p1[k]; } }
    { const f32x4 p0 = *(const f32x4*)(cb + c), p1 = *(const f32x4*)(cb + c + 4);
#pragma unroll
      for (int k = 0; k < 4; ++k) { bb[k] = p0[k]; bb[4 + k] = p1[k]; } }
    u32x4 gA[6], vA[4], gB[6], vB[4];
    int rq = gt / NCOL;
    if (rq < NQ) glu_load(gA, vA, UP, rq, c);
    while (rq < NQ) {
        int r2 = rq + nslab;
        if (r2 < NQ) glu_load(gB, vB, UP, r2, c);
        glu_compute(gA, vA, rq, c, w, bb, st, ACT);
        rq = r2; if (rq >= NQ) break;
        r2 = rq + nslab;
        if (r2 < NQ) glu_load(gA, vA, UP, r2, c);
        glu_compute(gB, vB, rq, c, w, bb, st, ACT);
        rq = r2;
    }
}
__device__ __forceinline__ void final_phase(const Ctx& a, bool dry) {
    const int lane = threadIdx.x & 63, gw = blockIdx.x * 8 + (threadIdx.x >> 6), NGW = gridDim.x * 8;
    const float* SS3 = (const float*)(a.ws + WS_SS3); const float* fg = a.in(34);
    for (int row = gw; row < T; row += NGW) {
        const float rs = rsqrtf(SS3[row] * (1.f / DM) + NORM_EPS);
        f32x4* o = (f32x4*)(a.out + (size_t)row * DM);
#pragma unroll
        for (int j = 0; j < 4; ++j) { const f32x4 g = ((const f32x4*)fg)[lane + 64 * j]; f32x4 v = o[lane + 64 * j]; const f32x4 vn = v * rs * g; o[lane + 64 * j] = dry ? v : vn; }
    }
}


#define XB_TMO      128
#define XB_XCNT(j)  (256  + 64 * (j))
#define XB_XSUB(j)  (1280 + 64 * (j))
#define XB_XGEN(j)  (2304 + 64 * (j))
#define XB_TOP      3328
#define XB_TOPGEN   3392
#define XCD_BAR_WORDS 3456
#define XB_SPIN_CAP (1u << 20)
__device__ __forceinline__ unsigned xb_ld(unsigned* p)              { return __hip_atomic_load(p, __ATOMIC_RELAXED, __HIP_MEMORY_SCOPE_AGENT); }
__device__ __forceinline__ unsigned xb_add(unsigned* p, unsigned v) { return __hip_atomic_fetch_add(p, v, __ATOMIC_RELAXED, __HIP_MEMORY_SCOPE_AGENT); }
__device__ __forceinline__ unsigned xb_xcc_id() { return (unsigned)__builtin_amdgcn_s_getreg((3 << 11) | 20) & 0xFu; }
#define XB_SPIN(cond, bar) do { unsigned _sp = 0; while (cond) { __builtin_amdgcn_s_sleep(1); \
    if ((++_sp & 255u) == 0u) { if (xb_ld(&(bar)[XB_TMO])) break; if (_sp > XB_SPIN_CAP) { atomicAdd(&(bar)[XB_TMO], 1u); break; } } } } while (0)
struct XcdBarrier { unsigned* bar; unsigned x; volatile LAS unsigned* st; };
__device__ __forceinline__ XcdBarrier xcd_barrier_post(unsigned* bar, volatile LAS unsigned* st) {
    XcdBarrier b; b.bar = bar; b.x = xb_xcc_id(); b.st = st;
    if (threadIdx.x == 0) (void)xb_add(&bar[XB_XCNT(b.x)], 1u);
    return b;
}
__device__ __forceinline__ void xcd_barrier_complete(unsigned* bar, unsigned x, unsigned& nloc, unsigned& nx) {
    const unsigned G = gridDim.x * gridDim.y * gridDim.z;
    unsigned sum, cnt, mine, sp = 0u;
    for (;;) {
        sum = 0u; cnt = 0u; mine = 0u;
#pragma unroll
        for (unsigned j = 0; j < 16; ++j) { const unsigned c = xb_ld(&bar[XB_XCNT(j)]); sum += c; cnt += (c > 0u) ? 1u : 0u; mine = (j == x) ? c : mine; }
        if (sum == G) break;
        __builtin_amdgcn_s_sleep(1);
        if ((++sp & 255u) == 0u) { if (xb_ld(&bar[XB_TMO])) break; if (sp > XB_SPIN_CAP) { atomicAdd(&bar[XB_TMO], 1u); break; } }
    }
    nloc = mine > 0u ? mine : 1u; nx = cnt > 0u ? cnt : 1u;
}
__device__ __forceinline__ void xcd_barrier(const XcdBarrier& b) {
    asm volatile("s_waitcnt vmcnt(0)" ::: "memory");
    __syncthreads();
    if (threadIdx.x == 0) {
        unsigned* bar = b.bar;
        __builtin_amdgcn_s_waitcnt(0);
        unsigned nloc = b.st[0], nx = b.st[1];
        if (nloc == 0u) { xcd_barrier_complete(bar, b.x, nloc, nx); b.st[0] = nloc; b.st[1] = nx; }
        const unsigned old = xb_add(&bar[XB_XSUB(b.x)], 1u);
        const unsigned gen = old / nloc;
        if (old + 1u == (gen + 1u) * nloc) {
            __builtin_amdgcn_fence(__ATOMIC_RELEASE, "agent");
            asm volatile("s_waitcnt vmcnt(0)" ::: "memory");
            const unsigned og = xb_add(&bar[XB_TOP], 1u);
            const unsigned tg = og / nx;
            if (og + 1u == (tg + 1u) * nx) xb_add(&bar[XB_TOPGEN], 1u);
            else XB_SPIN(xb_ld(&bar[XB_TOPGEN]) == tg, bar);
            __builtin_amdgcn_fence(__ATOMIC_ACQUIRE, "agent");
            xb_add(&bar[XB_XGEN(b.x)], 1u);
            asm volatile("s_waitcnt vmcnt(0)" ::: "memory");
        } else {
            XB_SPIN(xb_ld(&bar[XB_XGEN(b.x)]) == gen, bar);
            __builtin_amdgcn_fence(__ATOMIC_ACQUIRE, "agent");
            asm volatile("s_waitcnt vmcnt(0)" ::: "memory");
        }
    }
    __syncthreads();
}
#ifndef REPMASK
#define REPMASK 0
#endif
#ifndef PROBEVAR
#define PROBEVAR 0
#endif
#ifndef XSYNC
#define XSYNC 0
#endif
#ifndef DUPMASK
#define DUPMASK 0
#endif
#ifndef ONLYMODE
#define ONLYMODE 0
#endif
#ifndef SKIPM
#define SKIPM 0
#endif
__global__ void __launch_bounds__(512, 2) fwd_kernel(Args args) {
    extern __shared__ __attribute__((aligned(16))) unsigned char lds[];
    cg::grid_group grid = cg::this_grid();
    const int G = gridDim.x, bx = blockIdx.x;
    const int lo = args.ph_lo, hi = args.ph_hi;
    {
        unsigned long long* tb = (unsigned long long*)(lds + 131072);
        if (threadIdx.x < 35) tb[threadIdx.x] = (unsigned long long)args.in[threadIdx.x];
        __syncthreads();
    }
    Ctx a; a.ws = args.ws; a.out = args.out; a.tab = (const unsigned*)(lds + 131072);
    volatile LAS unsigned* bst = (volatile LAS unsigned*)((LAS unsigned char*)lds + 131072 + 2048);
    if (threadIdx.x < 2) bst[threadIdx.x] = 0u;
    __syncthreads();
    const XcdBarrier xbar = xcd_barrier_post((unsigned*)(args.ws + WS_BAR), bst);
#define IN(k) (lo <= (k) && (k) < hi)
#define PASSES(k) _Pragma("unroll 1") for (int pass = ((REPMASK >> (k)) & 1) ? 0 : 1; pass < 2; ++pass)
#define SEAM(k) do { if (IN(k) && IN((k) + 1)) { if (lo < 0) grid.sync(); else xcd_barrier(xbar); } } while (0)
#define RUN_GEMM(MODE, AP, LDA, BP, NN, KK, EP0, EP1) do { if (ONLYMODE != 0 && ONLYMODE != MODE) break; __syncthreads(); pg8::Gemm g{(const bf16_t*)(AP), (const bf16_t*)(BP), LDA, T, NN, KK}; \
        pg8::StaticOrder S; S.init(T, NN, G, bx); Epi<MODE> E{a.ws, a.out, EP0, EP1, (int)dry}; pg8::gemm_phase<Epi<MODE>, pg8::StaticOrder>((LAS unsigned char*)lds, g, S, E); } while (0)
    if (IN(0)) PASSES(0) { if (!(SKIPM & 1)) phase0(a, lds); }
    SEAM(0);
#if XSYNC
    for (int i = 0; i < XSYNC; ++i) grid.sync();
#endif
    if (IN(1)) PASSES(1) { const bool dry = pass == 0; if (!(SKIPM & 1024)) RUN_GEMM(1, a.ws + WS_XB, DM, a.ws + WS_WIN, PW, DM, a.in(11), nullptr); if (!(SKIPM & 1)) dt_phase(a); }
    SEAM(1);
    if (IN(2)) PASSES(2) { if (!(SKIPM & 2)) { lora_prep(a); conv_prepass(a); } }
    SEAM(2);
    if (IN(3)) {
#if DUPMASK & 1
        for (int u = bx; u < NBP * NH; u += G) ssd_prompt_unit(a, u >> 5, u & 31, lds, true);
#endif
#if DUPMASK & 2
        for (int u = bx; u < NBS * 4; u += G) ssd_sample_unit(a, u >> 2, u & 3, lds, true);
#endif
        if (!(SKIPM & 4)) for (int u = bx; u < NBP * NH; u += G) ssd_prompt_unit(a, u >> 5, u & 31, lds, false);
        if (!(SKIPM & 8)) for (int u = bx; u < NBS * 4; u += G) ssd_sample_unit(a, u >> 2, u & 3, lds, false);
    }
    SEAM(3);
    if (IN(4)) { const bool dry = false;
        if (!(SKIPM & 1024)) RUN_GEMM(2, a.ws + WS_LA, 256, a.ws + WS_WLO, 3072, 256, a.in(17), a.in(19));
        { const int skip = (G > 96) ? 48 : 0;
          if (bx >= skip && !(SKIPM & 16)) ya_norm(a, dry, (bx - skip) * 512 + (int)threadIdx.x, (G - skip) * 512); } }
    SEAM(4);
    if (IN(5)) PASSES(5) { if (!(SKIPM & 32)) rwkv_scalars(a); }
    SEAM(5);
    if (IN(6)) {
#if DUPMASK & 16
        for (int u = bx; u < NBS * 16; u += G) rwkv_sample_unit(a, u, lds);
#endif
#if DUPMASK & 32
        for (int u = bx; u < NBP * 16 * 2; u += G) rwkv_prompt_unit<PROBEVAR>(a, u, lds);
#endif
        if (!(SKIPM & 32)) for (int u = bx; u < NBS * 16; u += G) rwkv_sample_unit(a, u, lds);
        if (!(SKIPM & 64)) for (int u = bx; u < NBP * 16 * 2; u += G) rwkv_prompt_unit(a, u, lds);
    }
    SEAM(6);
    if (IN(7)) { const bool dry = false;
        if (!(SKIPM & 1024)) RUN_GEMM(3, (const bf16_t*)(a.ws + WS_PROJ) + PC_Z, PW, a.ws + WS_WA, DM, DI, nullptr, nullptr);
        { const int skip = (G > 32) ? 16 : 0;
          if (bx >= skip) { if (!(SKIPM & 128)) rwkv_post(a, dry, (bx - skip) * 8 + (int)(threadIdx.x >> 6), (G - skip) * 8);
                            if (!(SKIPM & 1)) tr_run(a, lds, TR_EARLY, TR_ALL, (bx - skip) * 8 + (int)(threadIdx.x >> 6), (G - skip) * 8); } } }
    SEAM(7);
    if (IN(8)) PASSES(8) { const bool dry = pass == 0; if (!(SKIPM & 1024)) RUN_GEMM(4, (const bf16_t*)(a.ws + WS_PROJ) + PC_YB, PW, a.ws + WS_WB, DM, DM, nullptr, nullptr); }
    SEAM(8);
    if (IN(9)) PASSES(9) { const bool dry = pass == 0; if (!(SKIPM & 1024)) RUN_GEMM(5, a.ws + WS_M, DM, a.ws + WS_WOUT, DM, DM, a.in(0), a.in(1)); }
    SEAM(9);
    if (IN(10)) PASSES(10) { const bool dry = pass == 0; if (!(SKIPM & 1024)) RUN_GEMM(6, a.ws + WS_X1B, DM, a.ws + WS_WUP, 5632, DM, nullptr, nullptr); }
    SEAM(10);
    if (IN(11)) PASSES(11) { if (!(SKIPM & 256)) glu_phase(a); }
    SEAM(11);
    if (IN(12)) PASSES(12) { const bool dry = pass == 0; if (!(SKIPM & 1024)) RUN_GEMM(7, a.ws + WS_ACT, DFF, a.ws + WS_WDN, DM, DFF, nullptr, nullptr); }
    SEAM(12);
    if (IN(13)) PASSES(13) { const bool dry = pass == 0; if (!(SKIPM & 512)) final_phase(a, dry); }
#undef IN
#undef PASSES
#undef SEAM
#undef RUN_GEMM
}

#ifndef MK_SPLIT
#define MK_SPLIT 0
#endif
extern "C" void kernel_launch(void* const* d_in, const int* in_sizes, int n_in, void* d_out, int out_size, void* d_ws, size_t ws_size, hipStream_t stream) {
    static int grid = 0;
    if (grid == 0) {
        if (n_in != 35 || (size_t)out_size != O_END || ws_size < WS_END) { fprintf(stderr, "kernel_launch: unexpected shapes: n_in %d out %d ws %zu\n", n_in, out_size, ws_size); grid = -1; return; }
        int dev = 0, cus = 0, per_cu = 0;
        hipGetDevice(&dev); hipDeviceGetAttribute(&cus, hipDeviceAttributeMultiprocessorCount, dev);
        hipFuncSetAttribute((const void*)fwd_kernel, hipFuncAttributeMaxDynamicSharedMemorySize, LDS_BYTES);
        hipOccupancyMaxActiveBlocksPerMultiprocessor(&per_cu, (const void*)fwd_kernel, 512, LDS_BYTES);
        if (per_cu < 1) per_cu = 1;
        grid = cus * per_cu;
        (void)hipGetLastError();
    }
    if (grid < 0) return;
    if (hipMemsetAsync((char*)d_ws + WS_BAR, 0, XCD_BAR_WORDS * 4, stream) != hipSuccess) { fprintf(stderr, "kernel_launch: memset failed\n"); return; }
    Args a{};
    for (int i = 0; i < 35; ++i) a.in[i] = (const float*)d_in[i];
    a.out = (float*)d_out; a.ws = (unsigned char*)d_ws; a.rep = REPMASK;
#if MK_SPLIT
    for (int ph = 0; ph < NPHASE; ++ph) { a.ph_lo = ph; a.ph_hi = ph + 1; void* args[] = {&a};
        hipError_t e = hipLaunchCooperativeKernel((const void*)fwd_kernel, dim3(grid), dim3(512), args, LDS_BYTES, stream);
        if (e != hipSuccess) { fprintf(stderr, "launch failed: %s\n", hipGetErrorString(e)); break; } }
#else
    a.ph_lo = 0; a.ph_hi = NPHASE; void* args[] = {&a};
    hipError_t e = hipLaunchCooperativeKernel((const void*)fwd_kernel, dim3(grid), dim3(512), args, LDS_BYTES, stream);
    if (e != hipSuccess) fprintf(stderr, "cooperative launch failed: %s (grid %d)\n", hipGetErrorString(e), grid);
#endif
}
```

```cpp
#include <hip/hip_runtime.h>
#include <hip/hip_cooperative_groups.h>
#include <cstdio>
#include <cstdint>
namespace cg = cooperative_groups;

#define LAS __attribute__((address_space(3)))
typedef unsigned short bf16_t;
typedef short bf16x8 __attribute__((ext_vector_type(8)));
typedef float f32x4 __attribute__((ext_vector_type(4)));
typedef unsigned u32x4 __attribute__((ext_vector_type(4)));
typedef unsigned u32x2 __attribute__((ext_vector_type(2)));

constexpr int DM = 1024, TP = 16384, TSMP = 1024, T = TP + TSMP, SEQ = 2048, DSEQ = 8, NBP = 8, NBS = 128;
constexpr int DI = 2048, CD = 3072, NH = 32, NS = 128, RSD = 3328, DFF = 2816;
constexpr int N1 = 10752, PW = 10496;
constexpr int PC_Z = 0, PC_XBC = 2048, PC_RW = 5120, PC_GT = 8448, PC_DT = 10496;
constexpr int PC_YB = 2048, PC_BV = 3072;
constexpr float NORM_EPS = 1e-5f, GN_EPS = 64e-5f;
constexpr size_t O_YP = 0, O_YS = (size_t)TP * DM, O_CONVP = O_YS + (size_t)TSMP * DM, O_SSMP = O_CONVP + (size_t)NBP * 3 * CD,
    O_SHIFTP = O_SSMP + (size_t)NBP * NH * 64 * NS, O_RWKVP = O_SHIFTP + (size_t)NBP * RSD, O_FFNP = O_RWKVP + (size_t)NBP * 16 * 64 * 64,
    O_CONVS = O_FFNP + (size_t)NBP * 2 * DFF, O_SSMS = O_CONVS + (size_t)NBS * 3 * CD, O_SHIFTS = O_SSMS + (size_t)NBS * NH * 64 * NS,
    O_RWKVS = O_SHIFTS + (size_t)NBS * RSD, O_FFNS = O_RWKVS + (size_t)NBS * 16 * 64 * 64, O_END = O_FFNS + (size_t)NBS * 2 * DFF;
constexpr size_t MiB = 1u << 20, U34 = 34 * MiB;
constexpr size_t WS_SSA = 0, WS_SS2 = WS_SSA + (size_t)T * 16, WS_SS3 = WS_SS2 + (size_t)T * 4, WS_RSTD1 = WS_SS3 + (size_t)T * 4;
constexpr size_t WS_BAR = 512 * 1024;
constexpr size_t WS_WIN = 1 * MiB, WS_WA = 22 * MiB, WS_WB = 26 * MiB, WS_WOUT = 28 * MiB, WS_WUP = 30 * MiB, WS_WDN = 41 * MiB, WS_WLO = 46 * MiB + 512 * 1024;
constexpr size_t WS_XB = 48 * MiB, WS_LOE = WS_XB, WS_PROJ = 82 * MiB, WS_DT = 431 * MiB, WS_LA = 434 * MiB, WS_LOA = 443 * MiB, WS_LOG = 477 * MiB;
constexpr size_t WS_XC = WS_LOA, WS_BC = WS_XB, WS_RWS = WS_LA;
constexpr size_t WS_MA = WS_LOA, WS_M = WS_LOG, WS_X1 = 82 * MiB, WS_X1B = 150 * MiB, WS_UP = 184 * MiB, WS_ACT = 371 * MiB, WS_END = 511 * MiB;
static_assert(WS_RSTD1 + (size_t)T * 4 <= WS_WIN && WS_PROJ + (size_t)T * PW * 2 <= WS_DT && WS_UP + (size_t)T * 5632 * 2 <= WS_ACT && WS_ACT + (size_t)T * DFF * 2 <= WS_END, "ws map");
constexpr int LDS_BYTES = 135168;
constexpr int NPHASE = 14;

__device__ __forceinline__ float bf2f(bf16_t u) { return __builtin_bit_cast(float, (unsigned)u << 16); }
__device__ __forceinline__ unsigned f2bf(float f) { unsigned u = __builtin_bit_cast(unsigned, f); return (u + 0x7fffu + ((u >> 16) & 1u)) >> 16; }
__device__ __forceinline__ unsigned pk2(float lo, float hi) { unsigned r; asm("v_cvt_pk_bf16_f32 %0, %1, %2" : "=v"(r) : "v"(lo), "v"(hi)); return r; }
__device__ __forceinline__ float lo16(unsigned w) { return __builtin_bit_cast(float, w << 16); }
__device__ __forceinline__ float hi16(unsigned w) { return __builtin_bit_cast(float, w & 0xffff0000u); }
__device__ __forceinline__ float sigmoidf_(float x) { return 1.f / (1.f + __expf(-x)); }
__device__ __forceinline__ float siluf_(float x) { return x / (1.f + __expf(-x)); }
__device__ __forceinline__ float softplusf_(float x) { return x > 20.f ? x : __logf(1.f + __expf(x)); }
__device__ __forceinline__ void rowinfo(int row, int& samp, int& b, int& t) {
    if (row < TP) { samp = 0; b = row >> 11; t = row & 2047; } else { const int r = row - TP; samp = 1; b = r >> 3; t = r & 7; }
}
__device__ __forceinline__ void lds_barrier() { asm volatile("s_waitcnt lgkmcnt(0)\n\ts_barrier" ::: "memory"); }
template <int CTRL> __device__ __forceinline__ float dppf(float v) { return __builtin_bit_cast(float, __builtin_amdgcn_update_dpp(0, __builtin_bit_cast(int, v), CTRL, 0xF, 0xF, true)); }
__device__ __forceinline__ float wave_sum(float v) {
    v += dppf<0xB1>(v); v += dppf<0x4E>(v); v += dppf<0x141>(v); v += dppf<0x140>(v);
    const int iv = __builtin_bit_cast(int, v);
    return (__builtin_bit_cast(float, __builtin_amdgcn_readlane(iv, 0)) + __builtin_bit_cast(float, __builtin_amdgcn_readlane(iv, 16))) +
           (__builtin_bit_cast(float, __builtin_amdgcn_readlane(iv, 32)) + __builtin_bit_cast(float, __builtin_amdgcn_readlane(iv, 48)));
}
__device__ __forceinline__ float sum8(float v) { v += dppf<0xB1>(v); v += dppf<0x4E>(v); v += dppf<0x141>(v); return v; }

struct Args { const float* in[35]; float* out; unsigned char* ws; int ph_lo, ph_hi, rep, pad; };
struct Ctx {
    unsigned char* ws; float* out; const unsigned* tab;
    __device__ __forceinline__ const float* in(int i) const {
        const unsigned lo = __builtin_amdgcn_readfirstlane(tab[2 * i]), hi = __builtin_amdgcn_readfirstlane(tab[2 * i + 1]);
        return (const float*)(((unsigned long long)hi << 32) | lo);
    }
};

namespace pg8 {
constexpr int BM = 256, BK = 64, HALF = 128, HTB = HALF * BK * 2, NXCD = 8, WGM = 8;
__host__ __device__ __forceinline__ int lds_byte(int r, int c) { const int st = (r >> 4) * 2 + (c >> 5), rr = r & 15, cc = c & 31, ob = rr * 64 + cc * 2; return st * 1024 + (ob ^ (((ob >> 9) & 1) << 5)); }
__host__ __device__ __forceinline__ void stage_rc(int b, int& R, int& C) { const int st = b / 1024, sb = b % 1024, swz = sb ^ (((sb >> 9) & 1) << 5); R = (st >> 1) * 16 + swz / 64; C = (st & 1) * 32 + (swz % 64) / 2; }
__host__ __device__ __forceinline__ int perm32(int rho) { const int n = rho >> 4, i = rho & 15; return 8 * (i >> 2) + 4 * n + (i & 3); }
struct Unit { int pm, pn; };
struct Gemm { const bf16_t* A; const bf16_t* Bt; int lda, M, N, K; };
struct StaticOrder {
    int nM, nN, nwg, G, c;
    __device__ void init(int M, int N, int G_, int c_) { nM = M / BM; nN = N / BM; nwg = nM * nN; G = G_; c = c_; }
    __device__ bool next(int i, Unit& u) const {
        const long L = (long)i * G + c; if (L >= nwg) return false;
        int wgid = (int)L; { const int q = nwg / NXCD, r = nwg % NXCD, xcd = wgid % NXCD, off = wgid / NXCD; wgid = (xcd < r ? xcd * (q + 1) : r * (q + 1) + (xcd - r) * q) + off; }
        const int nig = WGM * nN, gid = wgid / nig, fm = gid * WGM, gsz = (nM - fm) < WGM ? (nM - fm) : WGM;
        u.pm = fm + ((wgid % nig) % gsz); u.pn = (wgid % nig) / gsz; return true;
    }
};

template <class Epi, class Sched>
__device__ __forceinline__ void gemm_phase(LAS unsigned char* lds, const Gemm g, const Sched& S, const Epi& E) {
    const int tid = threadIdx.x, wid = __builtin_amdgcn_readfirstlane(tid >> 6), lane = tid & 63, wr = wid >> 2, wc = wid & 3, fr = lane & 15, fq = lane >> 4;
    const int K = g.K, nt = K / BK;
    unsigned voffA[2], voffB[2];
#pragma unroll
    for (int i = 0; i < 2; ++i) { int R, C; stage_rc(tid * 16 + i * 8192, R, C); const int Rb = (R & ~31) + perm32(R & 31);
        voffA[i] = (unsigned)(R * g.lda + C) * 2u; voffB[i] = (unsigned)(Rb * K + C) * 2u; }
    const size_t kstep = (size_t)(BK * 2);
    const size_t hstepA = (size_t)HALF * g.lda * 2, hstepB = (size_t)HALF * K * 2;
    const size_t tstepA = 2 * hstepA, tstepB = 2 * hstepB;
    const unsigned ldsw = (unsigned)wid * 1024u;
    const int aoff = lds_byte(wr * 64 + fr, fq * 8), boff = lds_byte(wc * 32 + fr, fq * 8);
#define PG8_SA(b, h) (((b) * 2 + (h)) * HTB)
#define PG8_SB(b, h) ((4 + (b) * 2 + (h)) * HTB)
#define PG8_STAGE(bufoff, gbase, voff) do { _Pragma("unroll") for (int _i = 0; _i < 2; ++_i) \
        __builtin_amdgcn_global_load_lds((const unsigned*)((const char*)(gbase) + (voff)[_i]), (LAS unsigned*)(lds + (bufoff) + ldsw + _i * 8192), 16, 0, 0); } while (0)
#define PG8_LDA(dst, b, h) do { _Pragma("unroll") for (int m = 0; m < 4; ++m) _Pragma("unroll") for (int k = 0; k < 2; ++k) dst[m][k] = *(const LAS bf16x8*)(lds + PG8_SA(b, h) + aoff + m * 2048 + k * 1024); } while (0)
#define PG8_LDB(dst, b, h) do { _Pragma("unroll") for (int n = 0; n < 2; ++n) _Pragma("unroll") for (int k = 0; k < 2; ++k) dst[n][k] = *(const LAS bf16x8*)(lds + PG8_SB(b, h) + boff + n * 2048 + k * 1024); } while (0)
#define PG8_MMA(ai, bj, At, Bt) do { __builtin_amdgcn_s_setprio(1); _Pragma("unroll") for (int m = 0; m < 4; ++m) _Pragma("unroll") for (int n = 0; n < 2; ++n) _Pragma("unroll") for (int k = 0; k < 2; ++k) \
        acc[ai][bj][m][n] = __builtin_amdgcn_mfma_f32_16x16x32_bf16(Bt[n][k], At[m][k], acc[ai][bj][m][n], 0, 0, 0); __builtin_amdgcn_s_setprio(0); } while (0)
#define PG8_WAIT_V(n) asm volatile("s_waitcnt vmcnt(" #n ")" ::: "memory")
#define PG8_WAIT_L(n) asm volatile("s_waitcnt lgkmcnt(" #n ")" ::: "memory")
#define PG8_BAR __builtin_amdgcn_s_barrier()
#define PG8_SCHED __builtin_amdgcn_sched_barrier(0)
    Unit cur, nxt; int ui = 0;
    if (!S.next(0, cur)) return;
    f32x4 acc[2][2][4][2];
#pragma unroll
    for (int a = 0; a < 2; ++a)
#pragma unroll
        for (int b = 0; b < 2; ++b)
#pragma unroll
            for (int m = 0; m < 4; ++m)
#pragma unroll
                for (int n = 0; n < 2; ++n) acc[a][b][m][n] = (f32x4){0.f, 0.f, 0.f, 0.f};
    bf16x8 At[4][2], B0[2][2], B1[2][2];
    const char* cA = (const char*)g.A + (size_t)cur.pm * tstepA; const char* cB = (const char*)g.Bt + (size_t)cur.pn * tstepB;
    PG8_STAGE(PG8_SB(0, 0), cB, voffB); PG8_STAGE(PG8_SB(0, 1), cB + hstepB, voffB); PG8_STAGE(PG8_SA(0, 0), cA, voffA); PG8_STAGE(PG8_SA(0, 1), cA + hstepA, voffA);
    if (wr == 1) PG8_BAR;
    PG8_WAIT_V(2); PG8_BAR;
    PG8_STAGE(PG8_SB(1, 0), cB + kstep, voffB); PG8_STAGE(PG8_SA(1, 0), cA + kstep, voffA); PG8_STAGE(PG8_SB(1, 1), cB + hstepB + kstep, voffB);
    PG8_WAIT_V(6); PG8_BAR;
    for (;;) {
        const bool has_next = S.next(ui + 1, nxt);
        const char* nA = has_next ? (const char*)g.A + (size_t)nxt.pm * tstepA : cA; const char* nB = has_next ? (const char*)g.Bt + (size_t)nxt.pn * tstepB : cB;
#pragma unroll 1
        for (int t = 0; t < nt; t += 2) {
            const bool last = (t == nt - 2);
            const char* a1 = cA + (size_t)(t + 1) * kstep;
            const char* a2 = last ? nA : cA + (size_t)(t + 2) * kstep; const char* b2 = last ? nB : cB + (size_t)(t + 2) * kstep;
            const char* a3 = a2 + kstep; const char* b3 = b2 + kstep;
            PG8_LDB(B0, 0, 0); PG8_LDB(B1, 0, 1); PG8_SCHED; PG8_LDA(At, 0, 0); PG8_STAGE(PG8_SA(1, 1), a1 + hstepA, voffA);
            PG8_WAIT_V(8); PG8_WAIT_L(0); PG8_BAR; PG8_MMA(0, 0, At, B0); PG8_MMA(0, 1, At, B1); PG8_BAR; PG8_SCHED;
            PG8_LDA(At, 0, 1); PG8_STAGE(PG8_SB(0, 0), b2, voffB); PG8_STAGE(PG8_SB(0, 1), b2 + hstepB, voffB); PG8_STAGE(PG8_SA(0, 0), a2, voffA);
            PG8_WAIT_V(8); PG8_WAIT_L(0); PG8_BAR; PG8_MMA(1, 0, At, B0); PG8_MMA(1, 1, At, B1); PG8_BAR; PG8_SCHED;
            PG8_LDB(B0, 1, 0); PG8_LDB(B1, 1, 1); PG8_SCHED; PG8_LDA(At, 1, 0); PG8_STAGE(PG8_SA(0, 1), a2 + hstepA, voffA);
            PG8_WAIT_V(8); PG8_WAIT_L(0); PG8_BAR; PG8_MMA(0, 0, At, B0); PG8_MMA(0, 1, At, B1); PG8_BAR; PG8_SCHED;
            PG8_LDA(At, 1, 1); PG8_STAGE(PG8_SB(1, 0), b3, voffB); PG8_STAGE(PG8_SB(1, 1), b3 + hstepB, voffB); PG8_STAGE(PG8_SA(1, 0), a3, voffA);
            PG8_WAIT_V(8); PG8_WAIT_L(0); PG8_BAR; PG8_MMA(1, 0, At, B0); PG8_MMA(1, 1, At, B1); PG8_BAR; PG8_SCHED;
        }
        if (wr == 0) PG8_BAR;
        E(acc, cur, wr, wc, fr, fq);
        if (!has_next) break;
#pragma unroll
        for (int a = 0; a < 2; ++a)
#pragma unroll
            for (int b = 0; b < 2; ++b)
#pragma unroll
                for (int m = 0; m < 4; ++m)
#pragma unroll
                    for (int n = 0; n < 2; ++n) acc[a][b][m][n] = (f32x4){0.f, 0.f, 0.f, 0.f};
        cur = nxt; cA = nA; cB = nB; ++ui;
        if (wr == 1) PG8_BAR;
    }
    PG8_WAIT_V(0);
    PG8_BAR;
#undef PG8_SA
#undef PG8_SB
#undef PG8_STAGE
#undef PG8_LDA
#undef PG8_LDB
#undef PG8_MMA
#undef PG8_WAIT_V
#undef PG8_WAIT_L
#undef PG8_BAR
#undef PG8_SCHED
}
}

__device__ __forceinline__ void st8bf(bf16_t* p, f32x4 a, f32x4 b) { u32x4 w; w.x = pk2(a[0], a[1]); w.y = pk2(a[2], a[3]); w.z = pk2(b[0], b[1]); w.w = pk2(b[2], b[3]); *(u32x4*)p = w; }

template <int SEG> __device__ __forceinline__ void epi1_seg(const f32x4 (&acc)[2][2][4][2], const pg8::Unit& u, int wr, int wc, int fr, int fq, unsigned char* ws, float* out, const float* dtb) {
    const int rbase = u.pm * 256 + wr * 64 + fr, cbase = u.pn * 256 + wc * 32 + 8 * fq;
    bf16_t* PROJ = (bf16_t*)(ws + WS_PROJ);
    float rsr[2][4];
#pragma unroll
    for (int ai = 0; ai < 2; ++ai)
#pragma unroll
        for (int m = 0; m < 4; ++m) rsr[ai][m] = ((const float*)(ws + WS_RSTD1))[rbase + ai * 128 + m * 16];
#pragma unroll
    for (int ai = 0; ai < 2; ++ai)
#pragma unroll
        for (int m = 0; m < 4; ++m) {
            const int row = rbase + ai * 128 + m * 16;
            int samp, b, t; rowinfo(row, samp, b, t);
            const int L = samp ? DSEQ : SEQ;
            const float rs = rsr[ai][m];
#pragma unroll
            for (int bj = 0; bj < 2; ++bj) {
                const int col = cbase + bj * 128;
                f32x4 v0 = acc[ai][bj][m][0] * rs, v1 = acc[ai][bj][m][1] * rs;
                if (SEG == 0) {
#pragma unroll
                    for (int i = 0; i < 4; ++i) { v0[i] = siluf_(v0[i]); v1[i] = siluf_(v1[i]); }
                    st8bf(PROJ + (size_t)row * PW + col, v0, v1);
                } else if (SEG == 1) {
                    st8bf(PROJ + (size_t)row * PW + col, v0, v1);
                    if (t >= L - 3) { float* o = out + (samp ? O_CONVS : O_CONVP) + (size_t)(b * 3 + (t - (L - 3))) * CD + (col - PC_XBC); *(f32x4*)o = v0; *(f32x4*)(o + 4) = v1; }
                } else if (SEG == 2) {
                    st8bf(PROJ + (size_t)row * PW + col, v0, v1);
                    if (t == L - 1) { float* o = out + (samp ? O_SHIFTS : O_SHIFTP) + (size_t)b * RSD + (col - PC_RW); *(f32x4*)o = v0; *(f32x4*)(o + 4) = v1; }
                } else if (SEG == 3) {
#pragma unroll
                    for (int i = 0; i < 4; ++i) { v0[i] = sigmoidf_(v0[i]); v1[i] = sigmoidf_(v1[i]); }
                    st8bf(PROJ + (size_t)row * PW + col, v0, v1);
                } else {
                    if (col < PC_DT + 32) {
                        const int c = col - PC_DT; float* d = (float*)(ws + WS_DT) + (size_t)row * 32 + c;
                        const f32x4 b0 = *(const f32x4*)(dtb + c), b1 = *(const f32x4*)(dtb + c + 4);
                        f32x4 o0, o1;
#pragma unroll
                        for (int i = 0; i < 4; ++i) { o0[i] = softplusf_(v0[i] + b0[i]); o1[i] = softplusf_(v1[i] + b1[i]); }
                        *(f32x4*)d = o0; *(f32x4*)(d + 4) = o1;
                    }
                }
            }
        }
}

template <int SEG> __device__ __forceinline__ void epi2_seg(const f32x4 (&acc)[2][2][4][2], const pg8::Unit& u, int wr, int wc, int fr, int fq, unsigned char* ws, const float* bias) {
    const int rbase = u.pm * 256 + wr * 64 + fr, cbase = (u.pn & 3) * 256 + wc * 32 + 8 * fq;
    bf16_t* O = (bf16_t*)(ws + (SEG == 0 ? WS_LOE : SEG == 1 ? WS_LOA : WS_LOG));
#pragma unroll
    for (int bj = 0; bj < 2; ++bj) {
        const int c = cbase + bj * 128;
        f32x4 b0 = {0.f, 0.f, 0.f, 0.f}, b1 = {0.f, 0.f, 0.f, 0.f};
        if (SEG < 2) { b0 = *(const f32x4*)(bias + c); b1 = *(const f32x4*)(bias + c + 4); }
#pragma unroll
        for (int ai = 0; ai < 2; ++ai)
#pragma unroll
            for (int m = 0; m < 4; ++m) {
                const int row = rbase + ai * 128 + m * 16;
                f32x4 v0 = acc[ai][bj][m][0], v1 = acc[ai][bj][m][1];
                if (SEG == 0) {
#pragma unroll
                    for (int i = 0; i < 4; ++i) { v0[i] = sigmoidf_(v0[i] + b0[i]) * 0.6065306597f; v1[i] = sigmoidf_(v1[i] + b1[i]) * 0.6065306597f; }
                } else if (SEG == 1) {
#pragma unroll
                    for (int i = 0; i < 4; ++i) { v0[i] = sigmoidf_(v0[i] + b0[i]); v1[i] = sigmoidf_(v1[i] + b1[i]); }
                }
                st8bf(O + (size_t)row * 1024 + c, v0, v1);
            }
    }
}
template <int MODE> struct Epi {
    static constexpr int mode = MODE; unsigned char* ws; float* out; const float* p0; const float* p1; int dry;
    __device__ __forceinline__ void operator()(const f32x4 (&acc)[2][2][4][2], const pg8::Unit& u, int wr, int wc, int fr, int fq) const {
        if (mode == 1) {
            if (u.pn < 8) epi1_seg<0>(acc, u, wr, wc, fr, fq, ws, out, p0); else if (u.pn < 20) epi1_seg<1>(acc, u, wr, wc, fr, fq, ws, out, p0);
            else if (u.pn < 33) epi1_seg<2>(acc, u, wr, wc, fr, fq, ws, out, p0); else if (u.pn < 41) epi1_seg<3>(acc, u, wr, wc, fr, fq, ws, out, p0);
            else epi1_seg<4>(acc, u, wr, wc, fr, fq, ws, out, p0);
            return;
        }
        if (mode == 2) {
            if (u.pn < 4) epi2_seg<0>(acc, u, wr, wc, fr, fq, ws, p0); else if (u.pn < 8) epi2_seg<1>(acc, u, wr, wc, fr, fq, ws, p1); else epi2_seg<2>(acc, u, wr, wc, fr, fq, ws, p0);
            return;
        }
        const int rbase = u.pm * 256 + wr * 64 + fr, cbase = u.pn * 256 + wc * 32 + 8 * fq;
        bf16_t* PROJ = (bf16_t*)(ws + WS_PROJ);
#pragma unroll
        for (int ai = 0; ai < 2; ++ai) {
            u32x4 la[4][2], lb[4][2]; f32x4 lx[4][2][2]; float rsv[4];
#pragma unroll
            for (int m = 0; m < 4; ++m) {
                const int row = rbase + ai * 128 + m * 16;
                if (mode == 6) rsv[m] = ((const float*)(ws + WS_SS2))[row];
#pragma unroll
                for (int bj = 0; bj < 2; ++bj) {
                    const int col = cbase + bj * 128;
                    if (mode == 3 || mode == 4) la[m][bj] = *(const u32x4*)(PROJ + (size_t)row * PW + PC_GT + (mode == 4 ? 1024 : 0) + col);
                    if (mode == 4) lb[m][bj] = *(const u32x4*)((const bf16_t*)(ws + WS_MA) + (size_t)row * 1024 + col);
                    if (mode == 5) { const float* xr = (row < TP ? p0 + (size_t)row * DM : p1 + (size_t)(row - TP) * DM) + col; lx[m][bj][0] = *(const f32x4*)xr; lx[m][bj][1] = *(const f32x4*)(xr + 4); }
                    if (mode == 7) la[m][bj] = *(const u32x4*)((const bf16_t*)(ws + WS_X1B) + (size_t)row * DM + col);
                }
            }
#pragma unroll
            for (int m = 0; m < 4; ++m) {
                const int row = rbase + ai * 128 + m * 16;
                int samp, b, t; rowinfo(row, samp, b, t);
                const int L = samp ? DSEQ : SEQ;
                float rs = 1.f;
                if (mode == 6) rs = rsqrtf(rsv[m] * (1.f / DM) + NORM_EPS);
                float ssq = 0.f;
#pragma unroll
                for (int bj = 0; bj < 2; ++bj) {
                    const int col = cbase + bj * 128;
                    f32x4 v0 = acc[ai][bj][m][0] * rs, v1 = acc[ai][bj][m][1] * rs;
                    if (mode == 3 || mode == 4) {
                        const u32x4 gw = la[m][bj];
                        f32x4 g0 = {lo16(gw.x), hi16(gw.x), lo16(gw.y), hi16(gw.y)}, g1 = {lo16(gw.z), hi16(gw.z), lo16(gw.w), hi16(gw.w)};
                        v0 = v0 * g0; v1 = v1 * g1;
                        if (mode == 3) st8bf((bf16_t*)(ws + WS_MA) + (size_t)row * 1024 + col, v0, v1);
                        else {
                            const u32x4 mw = lb[m][bj];
                            f32x4 m0 = {lo16(mw.x), hi16(mw.x), lo16(mw.y), hi16(mw.y)}, m1 = {lo16(mw.z), hi16(mw.z), lo16(mw.w), hi16(mw.w)};
                            st8bf((bf16_t*)(ws + WS_M) + (size_t)row * 1024 + col, v0 + m0, v1 + m1);
                        }
                    } else if (mode == 5) {
                        v0 = v0 + lx[m][bj][0]; v1 = v1 + lx[m][bj][1];
                        st8bf((bf16_t*)(ws + WS_X1B) + (size_t)row * DM + col, v0, v1);
#pragma unroll
                        for (int i = 0; i < 4; ++i) ssq += v0[i] * v0[i] + v1[i] * v1[i];
                    } else if (mode == 6) {
                        st8bf((bf16_t*)(ws + WS_UP) + (size_t)row * 5632 + col, v0, v1);
                        if (col < DFF && t >= L - 2) { float* o = out + (samp ? O_FFNS : O_FFNP) + (size_t)(b * 2 + (t - (L - 2))) * DFF + col; *(f32x4*)o = v0; *(f32x4*)(o + 4) = v1; }
                    } else {
                        const u32x4 xw = la[m][bj];
                        v0 = v0 + (f32x4){lo16(xw.x), hi16(xw.x), lo16(xw.y), hi16(xw.y)}; v1 = v1 + (f32x4){lo16(xw.z), hi16(xw.z), lo16(xw.w), hi16(xw.w)};
                        float* o = out + (size_t)row * DM + col; *(f32x4*)o = v0; *(f32x4*)(o + 4) = v1;
#pragma unroll
                        for (int i = 0; i < 4; ++i) ssq += v0[i] * v0[i] + v1[i] * v1[i];
                    }
                }
                if (mode == 5 || mode == 7) {
                    ssq += __shfl_xor(ssq, 16); ssq += __shfl_xor(ssq, 32);
                    if (fq == 0) atomicAdd((float*)(ws + (mode == 5 ? WS_SS2 : WS_SS3)) + row, dry ? 0.f : ssq);
                }
            }
        }
    }
};

struct TrItem { const float* W; int N, k0, n0; bf16_t* WT; int ldk, drow, dk; const float* kscale; };
constexpr int TR_EARLY = 16 * 329 + 32 * 32 + 16 * 32 + 32 + 32 + 64, TR_ALL = TR_EARLY + 16 * 32 + 16 * 176 + 44 * 32;
__device__ __forceinline__ TrItem tr_item(const Ctx& a, int it) {
    constexpr int I_IN = 16 * 329, I_A = 32 * 32, I_B = 16 * 32, I_O = 16 * 32, I_UP = 16 * 176, I_LW = 32, I_LA = 32, I_LG = 64;
    unsigned char* ws = a.ws; int r = it;
    if (r < I_IN) { const int kb = r / 329, nb = r % 329, n0 = 32 * nb; const int d = n0 < 5120 ? n0 : (n0 < 5152 ? PC_DT + (n0 - 5120) : n0 - 32);
        return TrItem{a.in(8), 10528, 64 * kb, n0, (bf16_t*)(ws + WS_WIN), 1024, d, 64 * kb, a.in(7)}; } r -= I_IN;
    if (r < I_A) return TrItem{a.in(15), 1024, 64 * (r / 32), 32 * (r % 32), (bf16_t*)(ws + WS_WA), 2048, 32 * (r % 32), 64 * (r / 32), nullptr}; r -= I_A;
    if (r < I_B) return TrItem{a.in(27), 1024, 64 * (r / 32), 32 * (r % 32), (bf16_t*)(ws + WS_WB), 1024, 32 * (r % 32), 64 * (r / 32), nullptr}; r -= I_B;
    if (r < I_LW) return TrItem{a.in(18), 1024, 0, 32 * r, (bf16_t*)(ws + WS_WLO), 256, 32 * r, 0, nullptr}; r -= I_LW;
    if (r < I_LA) return TrItem{a.in(20), 1024, 0, 32 * r, (bf16_t*)(ws + WS_WLO), 256, 1024 + 32 * r, 64, nullptr}; r -= I_LA;
    if (r < I_LG) return TrItem{a.in(21), 1024, 64 * (r / 32), 32 * (r % 32), (bf16_t*)(ws + WS_WLO), 256, 2048 + 32 * (r % 32), 128 + 64 * (r / 32), nullptr}; r -= I_LG;
    if (r < I_O) return TrItem{a.in(28), 1024, 64 * (r / 32), 32 * (r % 32), (bf16_t*)(ws + WS_WOUT), 1024, 32 * (r % 32), 64 * (r / 32), nullptr}; r -= I_O;
    if (r < I_UP) return TrItem{a.in(30), 5632, 64 * (r / 176), 32 * (r % 176), (bf16_t*)(ws + WS_WUP), 1024, 32 * (r % 176), 64 * (r / 176), a.in(29)}; r -= I_UP;
    return TrItem{a.in(33), 1024, 64 * (r / 32), 32 * (r % 32), (bf16_t*)(ws + WS_WDN), 2816, 32 * (r % 32), 64 * (r / 32), nullptr};
}
__device__ __forceinline__ void tr_load(const TrItem& d, float (&v)[32], float (&sc)[32], int lane) {
#pragma unroll
    for (int i = 0; i < 32; ++i) { const int kk = 2 * i + (lane >> 5); v[i] = d.W[(size_t)(d.k0 + kk) * d.N + d.n0 + (lane & 31)]; sc[i] = d.kscale ? d.kscale[d.k0 + kk] : 1.f; }
}
__device__ __forceinline__ void tr_store(const TrItem& d, const float (&v)[32], const float (&sc)[32], float* scr, int lane) {
#pragma unroll
    for (int i = 0; i < 32; ++i) { const int kk = 2 * i + (lane >> 5); scr[kk * 33 + (lane & 31)] = v[i] * sc[i]; }
    asm volatile("s_waitcnt lgkmcnt(0)" ::: "memory");
    const int c = lane & 7;
#pragma unroll
    for (int j = 0; j < 4; ++j) { const int n = (lane >> 3) + 8 * j; const float* s = scr + (8 * c) * 33 + n;
        u32x4 o; o.x = pk2(s[0 * 33], s[1 * 33]); o.y = pk2(s[2 * 33], s[3 * 33]); o.z = pk2(s[4 * 33], s[5 * 33]); o.w = pk2(s[6 * 33], s[7 * 33]);
        *(u32x4*)(d.WT + (size_t)(d.drow + n) * d.ldk + d.dk + 8 * c) = o; }
    asm volatile("s_waitcnt lgkmcnt(0)" ::: "memory");
}
__device__ __forceinline__ void tr_run(const Ctx& a, unsigned char* lds, int first, int NIT, int w0, int NGW) {
    const int lane = threadIdx.x & 63, wave = threadIdx.x >> 6;
    float* scr = (float*)(lds + wave * 16384);
    {
        float vA[32], sA[32], vB[32], sB[32];
        int it = first + w0;
        if (it < NIT) { const TrItem d = tr_item(a, it); tr_load(d, vA, sA, lane); }
        while (it < NIT) {
            int it2 = it + NGW;
            if (it2 < NIT) { const TrItem d = tr_item(a, it2); tr_load(d, vB, sB, lane); }
            { const TrItem d = tr_item(a, it); tr_store(d, vA, sA, scr, lane); }
            it = it2; if (it >= NIT) break;
            it2 = it + NGW;
            if (it2 < NIT) { const TrItem d = tr_item(a, it2); tr_load(d, vA, sA, lane); }
            { const TrItem d = tr_item(a, it); tr_store(d, vB, sB, scr, lane); }
            it = it2;
        }
    }
}
__device__ __forceinline__ void phase0(const Ctx& a, unsigned char* lds) {
    const int tid = threadIdx.x, lane = tid & 63, wave = tid >> 6;
    const int gw = blockIdx.x * 8 + wave, NGW = gridDim.x * 8;
    unsigned char* ws = a.ws;
    tr_run(a, lds, 0, TR_EARLY, gw, NGW);
    const int gt = blockIdx.x * 512 + tid, NGT = gridDim.x * 512;
    const u32x4 z4 = {0u, 0u, 0u, 0u};
    for (int i = gt; i < 224 * 128; i += NGT) *(u32x4*)(ws + WS_WIN + (size_t)10528 * 2048 + (size_t)i * 16) = z4;
    for (int i = gt; i < 3072 * 32; i += NGT) { const int row = i >> 5, c8 = (i & 31) * 8, seg = row >> 10;
        const bool nz = (seg == 0) ? (c8 < 64) : (seg == 1) ? (c8 >= 64 && c8 < 128) : (c8 >= 128);
        if (!nz) *(u32x4*)(ws + WS_WLO + ((size_t)row * 256 + c8) * 2) = z4; }
    for (int i = gt; i < T * 6; i += NGT) ((float*)(ws + WS_SSA))[i] = 0.f;
    for (int r0 = gw; r0 < T; r0 += 2 * NGW) {
        f32x4 v[2][4];
#pragma unroll
        for (int k = 0; k < 2; ++k) { const int row = r0 + k * NGW; if (row < T) {
            const float* xr = row < TP ? a.in(0) + (size_t)row * DM : a.in(1) + (size_t)(row - TP) * DM;
#pragma unroll
            for (int j = 0; j < 4; ++j) v[k][j] = ((const f32x4*)xr)[lane + 64 * j]; } }
#pragma unroll
        for (int k = 0; k < 2; ++k) { const int row = r0 + k * NGW; if (row < T) {
            float s = 0.f;
#pragma unroll
            for (int j = 0; j < 4; ++j) s += v[k][j][0] * v[k][j][0] + v[k][j][1] * v[k][j][1] + v[k][j][2] * v[k][j][2] + v[k][j][3] * v[k][j][3];
            s = wave_sum(s);
            if (lane == 0) ((float*)(ws + WS_RSTD1))[row] = rsqrtf(s * (1.f / DM) + NORM_EPS);
            u32x2* o = (u32x2*)(ws + WS_XB + (size_t)row * DM * 2);
#pragma unroll
            for (int j = 0; j < 4; ++j) { u32x2 w; w.x = pk2(v[k][j][0], v[k][j][1]); w.y = pk2(v[k][j][2], v[k][j][3]); o[lane + 64 * j] = w; } } }
    }
}

__device__ __forceinline__ void dt_phase(const Ctx& a) {
    const int lane = threadIdx.x & 63, fr = lane & 15, fq = lane >> 4, gw = blockIdx.x * 8 + (threadIdx.x >> 6), NGW = gridDim.x * 8;
    const bf16_t* XB = (const bf16_t*)(a.ws + WS_XB); const bf16_t* WIN = (const bf16_t*)(a.ws + WS_WIN);
    const float* rstd = (const float*)(a.ws + WS_RSTD1); const float* bias = a.in(11); float* DT = (float*)(a.ws + WS_DT);
    for (int rb = gw; rb < T / 16; rb += NGW) {
        const bf16_t* ap = XB + (size_t)(16 * rb + fr) * DM + 8 * fq; const bf16_t* bp = WIN + (size_t)(PC_DT + fr) * DM + 8 * fq;
        f32x4 acc0 = {0.f, 0.f, 0.f, 0.f}, acc1 = acc0;
#pragma unroll 1
        for (int k0 = 0; k0 < 32; k0 += 16) {
            bf16x8 av[16], b0[16], b1[16];
#pragma unroll
            for (int kk = 0; kk < 16; ++kk) { av[kk] = *(const bf16x8*)(ap + 32 * (k0 + kk)); b0[kk] = *(const bf16x8*)(bp + 32 * (k0 + kk)); b1[kk] = *(const bf16x8*)(bp + (size_t)16 * DM + 32 * (k0 + kk)); }
#pragma unroll
            for (int kk = 0; kk < 16; ++kk) { acc0 = __builtin_amdgcn_mfma_f32_16x16x32_bf16(av[kk], b0[kk], acc0, 0, 0, 0); acc1 = __builtin_amdgcn_mfma_f32_16x16x32_bf16(av[kk], b1[kk], acc1, 0, 0, 0); }
        }
        const float bc0 = bias[fr], bc1 = bias[16 + fr];
#pragma unroll
        for (int r = 0; r < 4; ++r) { const int row = 16 * rb + 4 * fq + r; const float rs = rstd[row];
            DT[(size_t)row * 32 + fr] = softplusf_(rs * acc0[r] + bc0); DT[(size_t)row * 32 + 16 + fr] = softplusf_(rs * acc1[r] + bc1); }
    }
}
__device__ __forceinline__ void unpack8(const u32x4 w, float (&f)[8]) { f[0] = lo16(w.x); f[1] = hi16(w.x); f[2] = lo16(w.y); f[3] = hi16(w.y); f[4] = lo16(w.z); f[5] = hi16(w.z); f[6] = lo16(w.w); f[7] = hi16(w.w); }
__device__ __forceinline__ u32x4 pack8(const float (&f)[8]) { u32x4 w; w.x = pk2(f[0], f[1]); w.y = pk2(f[2], f[3]); w.z = pk2(f[4], f[5]); w.w = pk2(f[6], f[7]); return w; }
__device__ __forceinline__ void lora_prep(const Ctx& a) {
    const bf16_t* PROJ = (const bf16_t*)(a.ws + WS_PROJ); bf16_t* LA = (bf16_t*)(a.ws + WS_LA);
    const float* mu = a.in(16); const float* sh = a.in(4);
    for (int i = blockIdx.x * 512 + threadIdx.x; i < T * 32; i += gridDim.x * 512) {
        const int row = i >> 5, j = (i & 31) * 8, c = 3072 + j;
        int samp, b, t; rowinfo(row, samp, b, t);
        float raw[8], prev[8], o[8];
        unpack8(*(const u32x4*)(PROJ + (size_t)row * PW + PC_RW + c), raw);
        if (t > 0) unpack8(*(const u32x4*)(PROJ + (size_t)(row - 1) * PW + PC_RW + c), prev);
        else {
#pragma unroll
            for (int k = 0; k < 8; ++k) prev[k] = samp ? sh[(size_t)b * RSD + c + k] : 0.f; }
#pragma unroll
        for (int k = 0; k < 8; ++k) { const float mx = raw[k] + (prev[k] - raw[k]) * mu[c + k]; o[k] = j < 64 ? tanhf(mx) : (j < 128 ? mx : sigmoidf_(mx)); }
        *(u32x4*)(LA + (size_t)row * 256 + j) = pack8(o);
    }
}

__device__ __forceinline__ void conv_load(u32x4 (&u)[11], const bf16_t* PROJ, int o, int cd) {
    const int row0 = 8 * o; const bool samp = row0 >= TP; const int t0 = samp ? 0 : (row0 & 2047);
    const bf16_t* src = PROJ + (size_t)row0 * PW + PC_XBC + cd;
#pragma unroll
    for (int i = 0; i < 3; ++i) { u[i] = (u32x4){0u, 0u, 0u, 0u}; if (t0 > 0) u[i] = *(const u32x4*)(src + (long)(i - 3) * PW); }
#pragma unroll
    for (int i = 3; i < 11; ++i) u[i] = *(const u32x4*)(src + (long)(i - 3) * PW);
}
__device__ __forceinline__ void conv_compute(const u32x4 (&u)[11], int o, int cd, const float (&w)[4][8], const float (&bb)[8], const float* cst, bf16_t* XC, bf16_t* BC) {
    const int row0 = 8 * o; const bool samp = row0 >= TP; const int b = (row0 - TP) >> 3;
    float x[11][8];
#pragma unroll
    for (int i = 0; i < 11; ++i) unpack8(u[i], x[i]);
    if (samp) {
#pragma unroll
        for (int i = 0; i < 3; ++i) { const f32x4 p0 = *(const f32x4*)(cst + (size_t)(b * 3 + i) * CD + cd), p1 = *(const f32x4*)(cst + (size_t)(b * 3 + i) * CD + cd + 4);
#pragma unroll
            for (int j = 0; j < 4; ++j) { x[i][j] = p0[j]; x[i][4 + j] = p1[j]; } }
    }
    bf16_t* dst = cd < 2048 ? XC + (size_t)row0 * 2048 + cd : BC + (size_t)row0 * 1024 + (cd - 2048);
    const int dld = cd < 2048 ? 2048 : 1024;
#pragma unroll
    for (int l = 0; l < 8; ++l) { float o8[8];
#pragma unroll
        for (int j = 0; j < 8; ++j) o8[j] = siluf_(bb[j] + w[0][j] * x[l][j] + w[1][j] * x[l + 1][j] + w[2][j] * x[l + 2][j] + w[3][j] * x[l + 3][j]);
        *(u32x4*)(dst + (size_t)l * dld) = pack8(o8); }
}
__device__ __forceinline__ void conv_prepass(const Ctx& a) {
    const bf16_t* PROJ = (const bf16_t*)(a.ws + WS_PROJ); bf16_t* XC = (bf16_t*)(a.ws + WS_XC); bf16_t* BC = (bf16_t*)(a.ws + WS_BC);
    const float* cw = a.in(9); const float* cbias = a.in(10); const float* cst = a.in(2);
    const int gt = blockIdx.x * 512 + threadIdx.x, NGT = gridDim.x * 512, NCOL = 384, nslab = NGT / NCOL;
    if (gt >= nslab * NCOL) return;
    const int cd = (gt % NCOL) * 8, NO = T / 8;
    float w[4][8], bb[8];
#pragma unroll
    for (int j = 0; j < 4; ++j) { const f32x4 p0 = *(const f32x4*)(cw + j * CD + cd), p1 = *(const f32x4*)(cw + j * CD + cd + 4);
#pragma unroll
        for (int k = 0; k < 4; ++k) { w[j][k] = p0[k]; w[j][4 + k] = p1[k]; } }
    { const f32x4 p0 = *(const f32x4*)(cbias + cd), p1 = *(const f32x4*)(cbias + cd + 4);
#pragma unroll
      for (int k = 0; k < 4; ++k) { bb[k] = p0[k]; bb[4 + k] = p1[k]; } }
    u32x4 uA[11], uB[11];
    int o = gt / NCOL;
    if (o < NO) conv_load(uA, PROJ, o, cd);
    while (o < NO) {
        int o2 = o + nslab;
        if (o2 < NO) conv_load(uB, PROJ, o2, cd);
        conv_compute(uA, o, cd, w, bb, cst, XC, BC);
        o = o2; if (o >= NO) break;
        o2 = o + nslab;
        if (o2 < NO) conv_load(uA, PROJ, o2, cd);
        conv_compute(uB, o, cd, w, bb, cst, XC, BC);
        o = o2;
    }
}

__device__ __forceinline__ void ssd_prompt_unit(const Ctx& a, int b, int head, unsigned char* lds, bool dry) {
    const int tid = threadIdx.x, lane = tid & 63, wave = tid >> 6, fr = lane & 15, fq = lane >> 4, g = head >> 3;
    bf16_t* Cs = (bf16_t*)lds;
    bf16_t* Bs = (bf16_t*)(lds + 17408);
    bf16_t* Hs = (bf16_t*)(lds + 34816);
    bf16_t* BwT = (bf16_t*)(lds + 52224);
    bf16_t* XT = (bf16_t*)(lds + 70656);
    bf16_t* Ps = (bf16_t*)(lds + 79872);
    bf16_t* Zs = (bf16_t*)(lds + 89088);
    bf16_t* Ys = (bf16_t*)(lds + 98304);
    float* csf = (float*)(lds + 107520); float* dtf = (float*)(lds + 107776);
    bf16_t* PROJ = (bf16_t*)(a.ws + WS_PROJ); const bf16_t* XC = (const bf16_t*)(a.ws + WS_XC); const bf16_t* BC = (const bf16_t*)(a.ws + WS_BC);
    const float* DT = (const float*)(a.ws + WS_DT); float* SSA = (float*)(a.ws + WS_SSA);
    const float Aneg = -__expf(a.in(12)[head]), Dh = a.in(13)[head];
    const int ll = tid >> 3, c8 = tid & 7, lb2 = tid >> 4, c16 = tid & 15;
    f32x4 hacc[4];
#pragma unroll
    for (int i = 0; i < 4; ++i) hacc[i] = (f32x4){0.f, 0.f, 0.f, 0.f};
    for (int i = tid; i < 64 * 136 / 2; i += 512) ((unsigned*)Hs)[i] = 0u;
    u32x4 rx, rz, rb0, rb1, rc0, rc1; float rdt = 0.f;
#define SSD_LOAD(c) do { const size_t r0_ = (size_t)b * SEQ + (size_t)(c) * 64; \
        rx = *(const u32x4*)(XC + (r0_ + ll) * 2048 + head * 64 + 8 * c8); rz = *(const u32x4*)(PROJ + (r0_ + ll) * PW + PC_Z + head * 64 + 8 * c8); \
        rb0 = *(const u32x4*)(BC + (r0_ + lb2) * 1024 + g * 128 + 8 * c16); rb1 = *(const u32x4*)(BC + (r0_ + 32 + lb2) * 1024 + g * 128 + 8 * c16); \
        rc0 = *(const u32x4*)(BC + (r0_ + lb2) * 1024 + 512 + g * 128 + 8 * c16); rc1 = *(const u32x4*)(BC + (r0_ + 32 + lb2) * 1024 + 512 + g * 128 + 8 * c16); \
        if (wave == 0) rdt = DT[(r0_ + lane) * 32 + head]; } while (0)
    SSD_LOAD(0);
    for (int c = 0; c < 32; ++c) {
        const int row0 = b * SEQ + c * 64;
        if (wave == 0) { float cs = rdt * Aneg;
#pragma unroll
            for (int o = 1; o < 64; o <<= 1) { const float v = __shfl_up(cs, o); if (lane >= o) cs += v; }
            csf[lane] = cs; dtf[lane] = rdt; }
        { const unsigned xw[4] = {rx.x, rx.y, rx.z, rx.w};
#pragma unroll
          for (int j = 0; j < 4; ++j) { XT[(8 * c8 + 2 * j) * 72 + ll] = (bf16_t)(xw[j] & 0xffffu); XT[(8 * c8 + 2 * j + 1) * 72 + ll] = (bf16_t)(xw[j] >> 16); } }
        *(u32x4*)(Zs + ll * 72 + 8 * c8) = rz;
        *(u32x4*)(Bs + lb2 * 136 + 8 * c16) = rb0; *(u32x4*)(Bs + (32 + lb2) * 136 + 8 * c16) = rb1;
        *(u32x4*)(Cs + lb2 * 136 + 8 * c16) = rc0; *(u32x4*)(Cs + (32 + lb2) * 136 + 8 * c16) = rc1;
        lds_barrier();
        if (c + 1 < 32) SSD_LOAD(c + 1);
        const float cs_last = csf[63];
        {
            const int n = tid & 127, lq = tid >> 7;
            float v[16];
#pragma unroll
            for (int i = 0; i < 16; ++i) { const int l = 16 * lq + i; v[i] = bf2f(Bs[l * 136 + n]) * dtf[l] * __expf(cs_last - csf[l]); }
            u32x4 w; w.x = pk2(v[0], v[1]); w.y = pk2(v[2], v[3]); w.z = pk2(v[4], v[5]); w.w = pk2(v[6], v[7]);
            *(u32x4*)(BwT + n * 72 + 16 * lq) = w;
            w.x = pk2(v[8], v[9]); w.y = pk2(v[10], v[11]); w.z = pk2(v[12], v[13]); w.w = pk2(v[14], v[15]);
            *(u32x4*)(BwT + n * 72 + 16 * lq + 8) = w;
        }
        {
            const int lb = wave >> 1;
#pragma unroll
            for (int j = 0; j < 2; ++j) {
                const int sb = 2 * (wave & 1) + j;
                f32x4 acc = {0.f, 0.f, 0.f, 0.f};
                if (sb <= lb) {
#pragma unroll
                    for (int kk = 0; kk < 4; ++kk) {
                        const bf16x8 av = *(const bf16x8*)(Cs + (16 * lb + fr) * 136 + 32 * kk + 8 * fq);
                        const bf16x8 bv = *(const bf16x8*)(Bs + (16 * sb + fr) * 136 + 32 * kk + 8 * fq);
                        acc = __builtin_amdgcn_mfma_f32_16x16x32_bf16(av, bv, acc, 0, 0, 0);
                    }
                }
                const int s = 16 * sb + fr; const float css = csf[s], dts = dtf[s];
#pragma unroll
                for (int r = 0; r < 4; ++r) { const int l = 16 * lb + 4 * fq + r;
                    const float p = (s <= l) ? acc[r] * __expf(csf[l] - css) * dts : 0.f;
                    Ps[l * 72 + s] = (bf16_t)f2bf(p); }
            }
        }
        lds_barrier();
        {
            const int lb = wave >> 1;
            float ssq[4] = {0.f, 0.f, 0.f, 0.f};
#pragma unroll
            for (int j = 0; j < 2; ++j) {
                const int pb = 2 * (wave & 1) + j;
                f32x4 yd = {0.f, 0.f, 0.f, 0.f}, yo = {0.f, 0.f, 0.f, 0.f};
#pragma unroll
                for (int kk = 0; kk < 2; ++kk) {
                    const bf16x8 av = *(const bf16x8*)(Ps + (16 * lb + fr) * 72 + 32 * kk + 8 * fq);
                    const bf16x8 bv = *(const bf16x8*)(XT + (16 * pb + fr) * 72 + 32 * kk + 8 * fq);
                    yd = __builtin_amdgcn_mfma_f32_16x16x32_bf16(av, bv, yd, 0, 0, 0);
                }
                if (c > 0) {
#pragma unroll
                    for (int kk = 0; kk < 4; ++kk) {
                        const bf16x8 av = *(const bf16x8*)(Cs + (16 * lb + fr) * 136 + 32 * kk + 8 * fq);
                        const bf16x8 bv = *(const bf16x8*)(Hs + (16 * pb + fr) * 136 + 32 * kk + 8 * fq);
                        yo = __builtin_amdgcn_mfma_f32_16x16x32_bf16(av, bv, yo, 0, 0, 0);
                    }
                }
                const int p = 16 * pb + fr;
#pragma unroll
                for (int r = 0; r < 4; ++r) { const int l = 16 * lb + 4 * fq + r;
                    const float x = bf2f(XT[p * 72 + l]);
                    const float y = yd[r] + yo[r] * __expf(csf[l]) + Dh * x;
                    const bf16_t zo = Zs[l * 72 + p]; const float yz = y * bf2f(zo);
                    Ys[l * 72 + p] = dry ? zo : (bf16_t)f2bf(yz); ssq[r] += yz * yz; }
            }
#pragma unroll
            for (int r = 0; r < 4; ++r) { float s = ssq[r]; s += dppf<0xB1>(s); s += dppf<0x4E>(s); s += dppf<0x141>(s); s += dppf<0x140>(s);
                if (fr == 0) atomicAdd(SSA + (size_t)(row0 + 16 * lb + 4 * fq + r) * 4 + g, dry ? 0.f : s); }
        }
        {
            const float dec = __expf(cs_last);
#pragma unroll
            for (int pb = 0; pb < 4; ++pb) {
                hacc[pb] = hacc[pb] * dec;
#pragma unroll
                for (int kk = 0; kk < 2; ++kk) {
                    const bf16x8 av = *(const bf16x8*)(XT + (16 * pb + fr) * 72 + 32 * kk + 8 * fq);
                    const bf16x8 bv = *(const bf16x8*)(BwT + (16 * wave + fr) * 72 + 32 * kk + 8 * fq);
                    hacc[pb] = __builtin_amdgcn_mfma_f32_16x16x32_bf16(av, bv, hacc[pb], 0, 0, 0);
                }
            }
        }
        lds_barrier();
#pragma unroll
        for (int pb = 0; pb < 4; ++pb)
#pragma unroll
            for (int r = 0; r < 4; ++r) Hs[(16 * pb + 4 * fq + r) * 136 + 16 * wave + fr] = (bf16_t)f2bf(hacc[pb][r]);
        *(u32x4*)(PROJ + (size_t)(row0 + ll) * PW + PC_Z + head * 64 + 8 * c8) = *(const u32x4*)(Ys + ll * 72 + 8 * c8);
    }
#undef SSD_LOAD
    float* so = a.out + O_SSMP + (size_t)(b * NH + head) * 64 * NS;
#pragma unroll
    for (int pb = 0; pb < 4; ++pb)
#pragma unroll
        for (int r = 0; r < 4; ++r) so[(16 * pb + 4 * fq + r) * NS + 16 * wave + fr] = hacc[pb][r];
    __syncthreads();
}

__device__ __forceinline__ void ssd_sample_unit(const Ctx& a, int b, int g, unsigned char* lds, bool dry) {
    const int tid = threadIdx.x;
    float* xs = (float*)lds;
    float* Bsm = (float*)(lds + 16384);
    float* Csm = (float*)(lds + 20480);
    float* dts = (float*)(lds + 24576);
    float* css = (float*)(lds + 24832);
    float* cbs = (float*)(lds + 25088);
    float* ssq = (float*)(lds + 25344);
    bf16_t* PROJ = (bf16_t*)(a.ws + WS_PROJ); const bf16_t* XC = (const bf16_t*)(a.ws + WS_XC); const bf16_t* BC = (const bf16_t*)(a.ws + WS_BC);
    const float* DT = (const float*)(a.ws + WS_DT);
    const int row0 = TP + b * 8;
    const int p = tid >> 3, nq = tid & 7;
    const float* hbase = a.in(3) + ((size_t)(b * NH + g * 8) * 64 + p) * NS + 16 * nq;
    f32x4 hq[4];
#pragma unroll
    for (int j = 0; j < 4; ++j) hq[j] = ((const f32x4*)hbase)[j];
#pragma unroll
    for (int l = 0; l < 8; ++l) xs[l * 512 + tid] = bf2f(XC[(size_t)(row0 + l) * 2048 + g * 512 + tid]);
    if (tid < 256) { const int which = tid >> 7, n = tid & 127; float* dst = which ? Csm : Bsm;
#pragma unroll
        for (int l = 0; l < 8; ++l) dst[l * 128 + n] = bf2f(BC[(size_t)(row0 + l) * 1024 + which * 512 + g * 128 + n]); }
    if (tid < 64) dts[tid] = DT[(size_t)(row0 + (tid >> 3)) * 32 + g * 8 + (tid & 7)];
    if (tid < 8) ssq[tid] = 0.f;
    __syncthreads();
    if (tid < 8) { const float An = -__expf(a.in(12)[g * 8 + tid]); float c = 0.f;
#pragma unroll
        for (int l = 0; l < 8; ++l) { c += dts[l * 8 + tid] * An; css[l * 8 + tid] = c; } }
    { const int pr = tid >> 3, l = pr >> 3, s = pr & 7; float d = 0.f;
#pragma unroll
        for (int j = 0; j < 16; ++j) d += Csm[l * 128 + 16 * nq + j] * Bsm[s * 128 + 16 * nq + j];
        d = sum8(d); if (nq == 0) cbs[l * 8 + s] = d; }
    __syncthreads();
    for (int hh = 0; hh < 8; ++hh) {
        const int head = g * 8 + hh;
        float h0[16];
#pragma unroll
        for (int j = 0; j < 4; ++j) { h0[4 * j] = hq[j][0]; h0[4 * j + 1] = hq[j][1]; h0[4 * j + 2] = hq[j][2]; h0[4 * j + 3] = hq[j][3]; }
        if (hh + 1 < 8) {
#pragma unroll
            for (int j = 0; j < 4; ++j) hq[j] = ((const f32x4*)(hbase + (size_t)(hh + 1) * 64 * NS))[j];
        }
        float csl[8], xl[8], dl[8];
#pragma unroll
        for (int l = 0; l < 8; ++l) { csl[l] = css[l * 8 + hh]; xl[l] = xs[l * 512 + hh * 64 + p]; dl[l] = dts[l * 8 + hh]; }
        float yoff[8];
#pragma unroll
        for (int l = 0; l < 8; ++l) { float s = 0.f;
#pragma unroll
            for (int j = 0; j < 16; ++j) s += Csm[l * 128 + 16 * nq + j] * h0[j];
            yoff[l] = sum8(s); }
        const float dec = __expf(csl[7]);
        float hn[16];
#pragma unroll
        for (int j = 0; j < 16; ++j) hn[j] = h0[j] * dec;
#pragma unroll
        for (int l = 0; l < 8; ++l) { const float w = xl[l] * dl[l] * __expf(csl[7] - csl[l]);
#pragma unroll
            for (int j = 0; j < 16; ++j) hn[j] += Bsm[l * 128 + 16 * nq + j] * w; }
        float* ho = a.out + O_SSMS + ((size_t)(b * NH + head) * 64 + p) * NS + 16 * nq;
#pragma unroll
        for (int j = 0; j < 4; ++j) ((f32x4*)ho)[j] = (f32x4){hn[4 * j], hn[4 * j + 1], hn[4 * j + 2], hn[4 * j + 3]};
        float yo = 0.f, cl = 0.f, xme = 0.f;
#pragma unroll
        for (int l = 0; l < 8; ++l) { if (nq == l) { yo = yoff[l]; cl = csl[l]; xme = xl[l]; } }
        float y = yo * __expf(cl) + a.in(13)[head] * xme;
#pragma unroll
        for (int s = 0; s < 8; ++s) { if (s <= nq) y += cbs[nq * 8 + s] * __expf(cl - csl[s]) * dl[s] * xl[s]; }
        bf16_t* zp = PROJ + (size_t)(row0 + nq) * PW + PC_Z + head * 64 + p;
        const bf16_t zo = *zp; const float yz = y * bf2f(zo);
        *zp = dry ? zo : (bf16_t)f2bf(yz);
        atomicAdd(ssq + nq, yz * yz);
    }
    __syncthreads();
    if (tid < 8) atomicAdd((float*)(a.ws + WS_SSA) + (size_t)(row0 + tid) * 4 + g, dry ? 0.f : ssq[tid]);
    __syncthreads();
}

__device__ __forceinline__ void ya_norm(const Ctx& a, bool dry, int gt0, int NGT) {
    bf16_t* PROJ = (bf16_t*)(a.ws + WS_PROJ); const float* SSA = (const float*)(a.ws + WS_SSA); const float* ng = a.in(14);
    for (int i0 = gt0; i0 < T * 256; i0 += 4 * NGT) {
        u32x4 w[4]; float rs[4];
#pragma unroll
        for (int k = 0; k < 4; ++k) { const int i = i0 + k * NGT; if (i < T * 256) { const int row = i >> 8, c = (i & 255) * 8;
            w[k] = *(const u32x4*)(PROJ + (size_t)row * PW + c); rs[k] = SSA[(size_t)row * 4 + (c >> 9)]; } }
#pragma unroll
        for (int k = 0; k < 4; ++k) { const int i = i0 + k * NGT; if (i < T * 256) { const int row = i >> 8, c = (i & 255) * 8;
            const float r = rsqrtf(rs[k] * (1.f / 512.f) + NORM_EPS);
            float f[8]; unpack8(w[k], f);
            const f32x4 g0 = *(const f32x4*)(ng + c), g1 = *(const f32x4*)(ng + c + 4);
#pragma unroll
            for (int j = 0; j < 4; ++j) { f[j] *= r * g0[j]; f[4 + j] *= r * g1[j]; }
            *(u32x4*)(PROJ + (size_t)row * PW + c) = dry ? w[k] : pack8(f); } }
    }
}

constexpr int RW_TB = 32, RW_STEPF = 388;
typedef float f32x2 __attribute__((ext_vector_type(2)));
struct RwConst { float mu_r, mu_k, mu_v, kk_w, ka_w, rk_w; };
__device__ __forceinline__ void rwkv_scalars(const Ctx& a) {
    bf16_t* PROJ = (bf16_t*)(a.ws + WS_PROJ); const bf16_t* LOA = (const bf16_t*)(a.ws + WS_LOA); float* RWS = (float*)(a.ws + WS_RWS);
    const int lane = threadIdx.x & 63, gw = blockIdx.x * 8 + (threadIdx.x >> 6), NGW = gridDim.x * 8;
    const float* sh = a.in(4);
    for (int item = gw; item < 2048; item += NGW) {
        const int half = item & 1, rbeg = (item >> 1) * 17, c0 = half * 512 + lane * 8, head = half * 8 + (lane >> 3);
        float mur[8], muk[8], muv[8], kkw[8], kaw[8], rkw[8];
#pragma unroll
        for (int j = 0; j < 2; ++j) {
            const f32x4 t0 = *(const f32x4*)(a.in(16) + c0 + 4 * j), t1 = *(const f32x4*)(a.in(16) + 1024 + c0 + 4 * j), t2 = *(const f32x4*)(a.in(16) + 2048 + c0 + 4 * j);
            const f32x4 t3 = *(const f32x4*)(a.in(22) + c0 + 4 * j), t4 = *(const f32x4*)(a.in(23) + c0 + 4 * j), t5 = *(const f32x4*)(a.in(24) + c0 + 4 * j);
#pragma unroll
            for (int k = 0; k < 4; ++k) { mur[4 * j + k] = t0[k]; muk[4 * j + k] = t1[k]; muv[4 * j + k] = t2[k]; kkw[4 * j + k] = t3[k]; kaw[4 * j + k] = t4[k]; rkw[4 * j + k] = t5[k]; }
        }
        const bf16_t* pr = PROJ + (size_t)rbeg * PW + PC_RW + c0;
        u32x4 pR = {0u, 0u, 0u, 0u}, pK = pR, pV = pR;
        if (rbeg > 0) { pR = *(const u32x4*)(pr - (long)PW); pK = *(const u32x4*)(pr + 1024 - (long)PW); pV = *(const u32x4*)(pr + 2048 - (long)PW); }
        u32x4 cR = *(const u32x4*)pr, cK = *(const u32x4*)(pr + 1024), cV = *(const u32x4*)(pr + 2048), cA = *(const u32x4*)(LOA + (size_t)rbeg * 1024 + c0);
        for (int i = 0; i < 17; ++i) {
            const int row = rbeg + i;
            u32x4 nR = cR, nK = cK, nV = cV, nA = cA;
            if (i + 1 < 17) { const bf16_t* pn = pr + (size_t)(i + 1) * PW; nR = *(const u32x4*)pn; nK = *(const u32x4*)(pn + 1024); nV = *(const u32x4*)(pn + 2048); nA = *(const u32x4*)(LOA + (size_t)(row + 1) * 1024 + c0); }
            int samp, b, t; rowinfo(row, samp, b, t);
            float rr[8], rk[8], rv[8], qr[8], qk[8], qv[8], av[8], vx[8];
            unpack8(cR, rr); unpack8(cK, rk); unpack8(cV, rv); unpack8(cA, av);
            if (t > 0) { unpack8(pR, qr); unpack8(pK, qk); unpack8(pV, qv); }
            else {
#pragma unroll
                for (int j = 0; j < 8; ++j) { const int c = c0 + j; qr[j] = samp ? sh[(size_t)b * RSD + c] : 0.f; qk[j] = samp ? sh[(size_t)b * RSD + 1024 + c] : 0.f; qv[j] = samp ? sh[(size_t)b * RSD + 2048 + c] : 0.f; } }
            float n2 = 0.f, brs = 0.f, krs = 0.f, bon = 0.f;
#pragma unroll
            for (int j = 0; j < 8; ++j) {
                const float r = rr[j] + (qr[j] - rr[j]) * mur[j], kx = rk[j] + (qk[j] - rk[j]) * muk[j]; vx[j] = rv[j] + (qv[j] - rv[j]) * muv[j];
                const float kkr = kx * kkw[j], kp = kx * (1.f + (av[j] - 1.f) * kaw[j]);
                n2 += kkr * kkr; brs += kkr * av[j] * r; krs += kp * r; bon += r * kp * rkw[j]; }
            n2 = sum8(n2); brs = sum8(brs); krs = sum8(krs); bon = sum8(bon);
            const float inv = 1.f / fmaxf(sqrtf(n2), 1e-12f);
            if ((lane & 7) == 0) *(f32x4*)(RWS + ((size_t)row * 16 + head) * 4) = (f32x4){inv, brs * inv, krs, bon};
            float o[8];
#pragma unroll
            for (int j = 0; j < 8; ++j) o[j] = bon * vx[j];
            *(u32x4*)(PROJ + (size_t)row * PW + PC_BV + c0) = pack8(o);
            pR = cR; pK = cK; pV = cV; cR = nR; cK = nK; cV = nV; cA = nA;
        }
    }
}
template <int NS, int NPRE> struct RwPrep { float rr[NS], rk[NS], rv[NS], le[NS], la[NS], lp[NPRE]; f32x4 sc[NS]; float q0r, q0k, q0v; int npre; };
template <int NS, int NPRE>
__device__ __forceinline__ void rwkv_prep_load(RwPrep<NS, NPRE>& P, const bf16_t* PROJ, const bf16_t* LOE, const bf16_t* LOA, const float* RWS, int row0, int tblock, int tfirst, int h, int lane, const float* shiftprev) {
    const int cr = h * 64 + lane;
    {
        const bf16_t* pr = PROJ + (size_t)(row0 + tfirst) * PW + PC_RW + cr;
        if (tfirst > 0) { P.q0r = bf2f(pr[-(long)PW]); P.q0k = bf2f(pr[1024 - (long)PW]); P.q0v = bf2f(pr[2048 - (long)PW]); }
        else if (shiftprev) { P.q0r = shiftprev[cr]; P.q0k = shiftprev[1024 + cr]; P.q0v = shiftprev[2048 + cr]; }
        else { P.q0r = 0.f; P.q0k = 0.f; P.q0v = 0.f; }
    }
    P.npre = tfirst - tblock;
#pragma unroll
    for (int j = 0; j < NPRE; ++j) { const int jj = j < P.npre ? j : 0; P.lp[j] = bf2f(LOE[(size_t)(row0 + tblock + jj) * 1024 + cr]); }
#pragma unroll
    for (int i = 0; i < NS; ++i) {
        const size_t row = (size_t)(row0 + tfirst + i);
        const bf16_t* pr = PROJ + row * PW + PC_RW + cr;
        P.rr[i] = bf2f(pr[0]); P.rk[i] = bf2f(pr[1024]); P.rv[i] = bf2f(pr[2048]);
        P.le[i] = bf2f(LOE[row * 1024 + cr]); P.la[i] = bf2f(LOA[row * 1024 + cr]);
        P.sc[i] = *(const f32x4*)(RWS + (row * 16 + h) * 4);
    }
}
template <int NS, int NPRE>
__device__ __forceinline__ void rwkv_prep_compute(const RwPrep<NS, NPRE>& P, float* slot0, int lane, const RwConst& K) {
    float esum = 0.f;
#pragma unroll
    for (int j = 0; j < NPRE; ++j) esum += (j < P.npre) ? P.lp[j] : 0.f;
    float Wprev = __expf(-esum);
#pragma unroll
    for (int i = 0; i < NS; ++i) {
        const float qr = i ? P.rr[i ? i - 1 : 0] : P.q0r, qk = i ? P.rk[i ? i - 1 : 0] : P.q0k, qv = i ? P.rv[i ? i - 1 : 0] : P.q0v;
        const float r = P.rr[i] + (qr - P.rr[i]) * K.mu_r, kx = P.rk[i] + (qk - P.rk[i]) * K.mu_k, vx = P.rv[i] + (qv - P.rv[i]) * K.mu_v;
        const float Wt = Wprev * __expf(-P.le[i]), inv = 1.f / Wt, av = P.la[i];
        const float kk = kx * K.kk_w * P.sc[i][0];
        const float kp = kx * (1.f + (av - 1.f) * K.ka_w), bb = kk * av;
        float* d = slot0 + (size_t)i * RW_STEPF;
        d[lane] = -kk * Wprev; d[64 + lane] = Wt * r; d[128 + lane] = Wt; d[192 + lane] = bb * inv; d[256 + lane] = kp * inv; d[320 + lane] = vx;
        if (lane == 0) { d[384] = P.sc[i][1]; d[385] = P.sc[i][2]; }
        Wprev = Wt;
    }
}
struct RwStep { f32x4 n, r, b, k; f32x2 vv, sc; };
__device__ __forceinline__ void rw_load(RwStep& R, const float* d, int q, int v0) {
    R.n = *(const f32x4*)(d + 4 * q); R.r = *(const f32x4*)(d + 64 + 4 * q);
    R.b = *(const f32x4*)(d + 192 + 4 * q); R.k = *(const f32x4*)(d + 256 + 4 * q);
    R.vv = *(const f32x2*)(d + 320 + v0); R.sc = *(const f32x2*)(d + 384);
}
#define LOH(x) __builtin_shufflevector(x, x, 0, 1)
#define HIH(x) __builtin_shufflevector(x, x, 2, 3)
__device__ __forceinline__ float sum16(float v) { v += dppf<0xB1>(v); v += dppf<0x4E>(v); v += dppf<0x141>(v); v += dppf<0x140>(v); return v; }
template <int VAR = 0> __device__ __forceinline__ void rw_step(f32x2 (&s)[2][2], const RwStep& c, int q, bf16_t* yo) {
    f32x2 a0 = s[0][0] * LOH(c.n), a1 = s[1][0] * LOH(c.n), e0 = s[0][0] * LOH(c.r), e1 = s[1][0] * LOH(c.r);
    a0 = s[0][1] * HIH(c.n) + a0; a1 = s[1][1] * HIH(c.n) + a1; e0 = s[0][1] * HIH(c.r) + e0; e1 = s[1][1] * HIH(c.r) + e1;
    float sa0 = a0.x + a0.y, sa1 = a1.x + a1.y, y20 = e0.x + e0.y, y21 = e1.x + e1.y;
    if (VAR != 1) { sa0 = sum16(sa0); sa1 = sum16(sa1); y20 = sum16(y20); y21 = sum16(y21); }
    const float y0 = y20 + sa0 * c.sc.x + c.vv.x * c.sc.y, y1 = y21 + sa1 * c.sc.x + c.vv.y * c.sc.y;
    const f32x2 s0v = {sa0, sa0}, s1v = {sa1, sa1}, v0v = {c.vv.x, c.vv.x}, v1v = {c.vv.y, c.vv.y};
    s[0][0] = s0v * LOH(c.b) + (v0v * LOH(c.k) + s[0][0]);
    s[0][1] = s0v * HIH(c.b) + (v0v * HIH(c.k) + s[0][1]);
    s[1][0] = s1v * LOH(c.b) + (v1v * LOH(c.k) + s[1][0]);
    s[1][1] = s1v * HIH(c.b) + (v1v * HIH(c.k) + s[1][1]);
    if (q == 0) *(unsigned*)yo = pk2(y0, y1);
}
template <int VAR = 0> __device__ __forceinline__ void rwkv_scan_block(f32x2 (&s)[2][2], const float* stp, int nb, int q, int v0, bf16_t* yo) {
    RwStep c0, c1; rw_load(c0, stp, q, v0);
    if (VAR == 5) {
        c1 = c0;
        for (int tt = 0; tt < nb; tt += 2) { rw_step<0>(s, c0, q, yo + (size_t)tt * PW); rw_step<0>(s, c1, q, yo + (size_t)(tt + 1) * PW); }
    } else if (VAR == 6) {
        f32x4 accv = {0.f, 0.f, 0.f, 0.f};
        for (int tt = 0; tt < nb; tt += 2) {
            rw_load(c1, stp + (size_t)(tt + 1) * RW_STEPF, q, v0); accv = accv + c0.n + c0.r + c0.b + c0.k;
            rw_load(c0, stp + (size_t)((tt + 2 < nb) ? tt + 2 : tt) * RW_STEPF, q, v0); accv = accv + c1.n + c1.r + c1.b + c1.k;
        }
        s[0][0] = LOH(accv); s[0][1] = HIH(accv);
    } else
    for (int tt = 0; tt < nb; tt += 2) {
        rw_load(c1, stp + (size_t)(tt + 1) * RW_STEPF, q, v0);
        rw_step<VAR>(s, c0, q, yo + (size_t)tt * PW);
        rw_load(c0, stp + (size_t)((tt + 2 < nb) ? tt + 2 : tt) * RW_STEPF, q, v0);
        rw_step<VAR>(s, c1, q, yo + (size_t)(tt + 1) * PW);
    }
    const f32x4 wend = *(const f32x4*)(stp + (size_t)(nb - 1) * RW_STEPF + 128 + 4 * q);
#pragma unroll
    for (int i = 0; i < 2; ++i) { s[i][0] = s[i][0] * LOH(wend); s[i][1] = s[i][1] * HIH(wend); }
}
__device__ __forceinline__ void rw_state_load(f32x2 (&s)[2][2], const float* S0, int v0, int q) {
#pragma unroll
    for (int i = 0; i < 2; ++i) { const f32x4 t = *(const f32x4*)(S0 + (v0 + i) * 64 + 4 * q); s[i][0] = LOH(t); s[i][1] = HIH(t); }
}
__device__ __forceinline__ void rw_state_store(const f32x2 (&s)[2][2], float* So, int v0, int q) {
#pragma unroll
    for (int i = 0; i < 2; ++i) *(f32x4*)(So + (v0 + i) * 64 + 4 * q) = (f32x4){s[i][0].x, s[i][0].y, s[i][1].x, s[i][1].y};
}
__device__ __forceinline__ RwConst rw_consts(const Ctx& a, int cr) {
    RwConst K; K.mu_r = a.in(16)[cr]; K.mu_k = a.in(16)[1024 + cr]; K.mu_v = a.in(16)[2048 + cr]; K.kk_w = a.in(22)[cr]; K.ka_w = a.in(23)[cr]; K.rk_w = a.in(24)[cr]; return K;
}
__device__ __forceinline__ void rwkv_sample_unit(const Ctx& a, int u, unsigned char* lds) {
    const int tid = threadIdx.x, lane = tid & 63, wave = tid >> 6, b = u >> 4, h = u & 15, cr = h * 64 + lane;
    float* stp = (float*)lds; bf16_t* PROJ = (bf16_t*)(a.ws + WS_PROJ);
    const int row0 = TP + b * 8, v = wave * 8 + 2 * (lane >> 4), q = lane & 15;
    f32x2 s[2][2]; rw_state_load(s, a.in(5) + (size_t)u * 4096, v, q);
    const RwConst K = rw_consts(a, cr);
    { RwPrep<1, 7> P; rwkv_prep_load<1, 7>(P, PROJ, (const bf16_t*)(a.ws + WS_LOE), (const bf16_t*)(a.ws + WS_LOA), (const float*)(a.ws + WS_RWS), row0, 0, wave, h, lane, a.in(4) + (size_t)b * RSD);
      rwkv_prep_compute<1, 7>(P, stp + wave * RW_STEPF, lane, K); }
    __syncthreads();
    rwkv_scan_block(s, stp, 8, q, v, PROJ + (size_t)row0 * PW + PC_YB + h * 64 + v);
    rw_state_store(s, a.out + O_RWKVS + (size_t)u * 4096, v, q);
    __syncthreads();
}
struct RwStep1 { f32x4 n, r, w, b, k; float vv; f32x2 sc; };
__device__ __forceinline__ void rw_load1(RwStep1& R, const float* d, int q, int v) {
    R.n = *(const f32x4*)(d + 4 * q); R.r = *(const f32x4*)(d + 64 + 4 * q); R.w = *(const f32x4*)(d + 128 + 4 * q);
    R.b = *(const f32x4*)(d + 192 + 4 * q); R.k = *(const f32x4*)(d + 256 + 4 * q);
    R.vv = d[320 + v]; R.sc = *(const f32x2*)(d + 384);
}
__device__ __forceinline__ void rw_step1(f32x2 (&s)[2], const RwStep1& c, int q, bf16_t* yo) {
    f32x2 a0 = s[0] * LOH(c.n), e0 = s[0] * LOH(c.r);
    a0 = s[1] * HIH(c.n) + a0; e0 = s[1] * HIH(c.r) + e0;
    const float sa = sum16(a0.x + a0.y), y2 = sum16(e0.x + e0.y);
    const float y = y2 + sa * c.sc.x + c.vv * c.sc.y;
    const f32x2 sav = {sa, sa}, vvv = {c.vv, c.vv};
    s[0] = s[0] * LOH(c.w) + (sav * LOH(c.b) + vvv * LOH(c.k));
    s[1] = s[1] * HIH(c.w) + (sav * HIH(c.b) + vvv * HIH(c.k));
    if (q == 0) *yo = (bf16_t)f2bf(y);
}
template <int VAR = 0> __device__ __forceinline__ void rwkv_prompt_unit(const Ctx& a, int u, unsigned char* lds) {
    const int tid = threadIdx.x, lane = tid & 63, wave = tid >> 6, bh = u >> 1, half = u & 1, b = bh >> 4, h = bh & 15, cr = h * 64 + lane;
    float* buf = (float*)lds; bf16_t* PROJ = (bf16_t*)(a.ws + WS_PROJ);
    const bf16_t* LOE = (const bf16_t*)(a.ws + WS_LOE); const bf16_t* LOA = (const bf16_t*)(a.ws + WS_LOA);
    const int row0 = b * SEQ, v = half * 32 + (wave & 3) * 8 + 2 * (lane >> 4), q = lane & 15, pw = wave - 4;
    constexpr int NBLK = SEQ / RW_TB, BUFF = RW_TB * RW_STEPF;
    f32x2 s[2][2] = {{{0.f, 0.f}, {0.f, 0.f}}, {{0.f, 0.f}, {0.f, 0.f}}};
    const RwConst K = rw_consts(a, cr);
    const float* RWS = (const float*)(a.ws + WS_RWS);
    RwPrep<8, 24> P;
    if (wave >= 4) { rwkv_prep_load<8, 24>(P, PROJ, LOE, LOA, RWS, row0, 0, 8 * pw, h, lane, nullptr); rwkv_prep_compute<8, 24>(P, buf + 8 * pw * RW_STEPF, lane, K);
        rwkv_prep_load<8, 24>(P, PROJ, LOE, LOA, RWS, row0, RW_TB, RW_TB + 8 * pw, h, lane, nullptr); }
    else __builtin_amdgcn_s_setprio(2);
    lds_barrier();
    for (int blk = 0; blk < NBLK; ++blk) {
        if (wave < 4) { if (VAR != 2) rwkv_scan_block<VAR>(s, buf + (blk & 1) * BUFF, RW_TB, q, v, PROJ + (size_t)(row0 + blk * RW_TB) * PW + PC_YB + h * 64 + v); }
        else if (blk + 1 < NBLK && VAR != 3) { rwkv_prep_compute<8, 24>(P, buf + ((blk + 1) & 1) * BUFF + 8 * pw * RW_STEPF, lane, K);
            if (blk + 2 < NBLK) rwkv_prep_load<8, 24>(P, PROJ, LOE, LOA, RWS, row0, (blk + 2) * RW_TB, (blk + 2) * RW_TB + 8 * pw, h, lane, nullptr); }
        lds_barrier();
    }
    __builtin_amdgcn_s_setprio(0);
    __syncthreads();
    if (wave < 4) rw_state_store(s, a.out + O_RWKVP + (size_t)bh * 4096, v, q);
}
__device__ __forceinline__ void rwkv_post(const Ctx& a, bool dry, int gw, int NGW) {
    bf16_t* PROJ = (bf16_t*)(a.ws + WS_PROJ); const bf16_t* LOG = (const bf16_t*)(a.ws + WS_LOG);
    const int lane = threadIdx.x & 63, c0 = lane * 16;
    float lw[16], lb[16];
#pragma unroll
    for (int j = 0; j < 4; ++j) { const f32x4 x = *(const f32x4*)(a.in(25) + c0 + 4 * j), y = *(const f32x4*)(a.in(26) + c0 + 4 * j);
#pragma unroll
        for (int k = 0; k < 4; ++k) { lw[4 * j + k] = x[k]; lb[4 * j + k] = y[k]; } }
    for (int r0 = gw; r0 < T; r0 += 2 * NGW) {
        u32x4 yw[2][2], bw[2][2], gw4[2][2];
#pragma unroll
        for (int k = 0; k < 2; ++k) { const int row = r0 + k * NGW; if (row < T) {
            const bf16_t* yp = PROJ + (size_t)row * PW + PC_YB + c0; const bf16_t* bp = PROJ + (size_t)row * PW + PC_BV + c0; const bf16_t* gp = LOG + (size_t)row * 1024 + c0;
            yw[k][0] = *(const u32x4*)yp; yw[k][1] = *(const u32x4*)(yp + 8); bw[k][0] = *(const u32x4*)bp; bw[k][1] = *(const u32x4*)(bp + 8); gw4[k][0] = *(const u32x4*)gp; gw4[k][1] = *(const u32x4*)(gp + 8); } }
#pragma unroll
        for (int k = 0; k < 2; ++k) { const int row = r0 + k * NGW; if (row < T) {
            float y[16], bv[16], gg[16];
            { float t8[8]; unpack8(yw[k][0], t8);
#pragma unroll
              for (int j = 0; j < 8; ++j) y[j] = t8[j];
              unpack8(yw[k][1], t8);
#pragma unroll
              for (int j = 0; j < 8; ++j) y[8 + j] = t8[j];
              unpack8(bw[k][0], t8);
#pragma unroll
              for (int j = 0; j < 8; ++j) bv[j] = t8[j];
              unpack8(bw[k][1], t8);
#pragma unroll
              for (int j = 0; j < 8; ++j) bv[8 + j] = t8[j];
              unpack8(gw4[k][0], t8);
#pragma unroll
              for (int j = 0; j < 8; ++j) gg[j] = t8[j];
              unpack8(gw4[k][1], t8);
#pragma unroll
              for (int j = 0; j < 8; ++j) gg[8 + j] = t8[j]; }
            float sm = 0.f;
#pragma unroll
            for (int j = 0; j < 16; ++j) sm += y[j];
            sm += dppf<0xB1>(sm); sm += dppf<0x4E>(sm);
            const float mean = sm * (1.f / 64.f); float sv = 0.f;
#pragma unroll
            for (int j = 0; j < 16; ++j) { const float d = y[j] - mean; sv += d * d; }
            sv += dppf<0xB1>(sv); sv += dppf<0x4E>(sv);
            const float rstd = rsqrtf(sv * (1.f / 64.f) + GN_EPS);
            float o[16];
#pragma unroll
            for (int j = 0; j < 16; ++j) o[j] = ((y[j] - mean) * rstd * lw[j] + lb[j] + bv[j]) * gg[j];
            bf16_t* yp = PROJ + (size_t)row * PW + PC_YB + c0;
            u32x4 o0, o1; o0.x = pk2(o[0], o[1]); o0.y = pk2(o[2], o[3]); o0.z = pk2(o[4], o[5]); o0.w = pk2(o[6], o[7]); o1.x = pk2(o[8], o[9]); o1.y = pk2(o[10], o[11]); o1.z = pk2(o[12], o[13]); o1.w = pk2(o[14], o[15]);
            *(u32x4*)yp = dry ? yw[k][0] : o0; *(u32x4*)(yp + 8) = dry ? yw[k][1] : o1; } }
    }
}

__device__ __forceinline__ void glu_load(u32x4 (&g)[6], u32x4 (&v)[4], const bf16_t* UP, int rq, int c) {
    const int row = 4 * rq; int samp, b, t; rowinfo(row, samp, b, t);
#pragma unroll
    for (int k = 0; k < 4; ++k) { g[2 + k] = *(const u32x4*)(UP + (size_t)(row + k) * 5632 + c); v[k] = *(const u32x4*)(UP + (size_t)(row + k) * 5632 + DFF + c); }
    g[0] = (u32x4){0u, 0u, 0u, 0u}; g[1] = g[0];
    if (t >= 2) { g[0] = *(const u32x4*)(UP + (size_t)(row - 2) * 5632 + c); g[1] = *(const u32x4*)(UP + (size_t)(row - 1) * 5632 + c); }
}
__device__ __forceinline__ void glu_compute(const u32x4 (&g)[6], const u32x4 (&v)[4], int rq, int c, const float (&w)[3][8], const float (&bb)[8], const float* st, bf16_t* ACT) {
    const int row = 4 * rq; int samp, b, t; rowinfo(row, samp, b, t);
    float ug[6][8];
#pragma unroll
    for (int k = 0; k < 6; ++k) unpack8(g[k], ug[k]);
    if (samp && t < 2) {
#pragma unroll
        for (int i = 0; i < 2; ++i) { const f32x4 p0 = *(const f32x4*)(st + (size_t)(b * 2 + i) * DFF + c), p1 = *(const f32x4*)(st + (size_t)(b * 2 + i) * DFF + c + 4);
#pragma unroll
            for (int j = 0; j < 4; ++j) { ug[i][j] = p0[j]; ug[i][4 + j] = p1[j]; } }
    }
#pragma unroll
    for (int k = 0; k < 4; ++k) { float uv[8], o[8]; unpack8(v[k], uv);
#pragma unroll
        for (int j = 0; j < 8; ++j) { const float gte = bb[j] + w[0][j] * ug[k][j] + w[1][j] * ug[k + 1][j] + w[2][j] * ug[k + 2][j]; o[j] = siluf_(gte) * uv[j]; }
        *(u32x4*)(ACT + (size_t)(row + k) * DFF + c) = pack8(o); }
}
__device__ __forceinline__ void glu_phase(const Ctx& a) {
    const bf16_t* UP = (const bf16_t*)(a.ws + WS_UP); bf16_t* ACT = (bf16_t*)(a.ws + WS_ACT);
    const float* cw = a.in(31); const float* cb = a.in(32); const float* st = a.in(6);
    const int gt = blockIdx.x * 512 + threadIdx.x, NGT = gridDim.x * 512, NCOL = 352, nslab = NGT / NCOL;
    if (gt >= nslab * NCOL) return;
    const int c = (gt % NCOL) * 8, NQ = T / 4;
    float w[3][8], bb[8];
#pragma unroll
    for (int j = 0; j < 3; ++j) { const f32x4 p0 = *(const f32x4*)(cw + j * DFF + c), p1 = *(const f32x4*)(cw + j * DFF + c + 4);
#pragma unroll
        for (int k = 0; k < 4; ++k) { w[j][k] = p0[k]; w[j][4 + k] = p1[k]; } }
    { const f32x4 p0 = *(const f32x4*)(cb + c), p1 = *(const f32x4*)(cb + c + 4);
#pragma unroll
      for (int k = 0; k < 4; ++k) { bb[k] = p0[k]; bb[4 + k] = p1[k]; } }
    u32x4 gA[6], vA[4], gB[6], vB[4];
    int rq = gt / NCOL;
    if (rq < NQ) glu_load(gA, vA, UP, rq, c);
    while (rq < NQ) {
        int r2 = rq + nslab;
        if (r2 < NQ) glu_load(gB, vB, UP, r2, c);
        glu_compute(gA, vA, rq, c, w, bb, st, ACT);
        rq = r2; if (rq >= NQ) break;
        r2 = rq + nslab;
        if (r2 < NQ) glu_load(gA, vA, UP, r2, c);
        glu_compute(gB, vB, rq, c, w, bb, st, ACT);
        rq = r2;
    }
}
__device__ __forceinline__ void final_phase(const Ctx& a, bool dry) {
    const int lane = threadIdx.x & 63, gw = blockIdx.x * 8 + (threadIdx.x >> 6), NGW = gridDim.x * 8;
    const float* SS3 = (const float*)(a.ws + WS_SS3); const float* fg = a.in(34);
    for (int row = gw; row < T; row += NGW) {
        const float rs = rsqrtf(SS3[row] * (1.f / DM) + NORM_EPS);
        f32x4* o = (f32x4*)(a.out + (size_t)row * DM);
#pragma unroll
        for (int j = 0; j < 4; ++j) { const f32x4 g = ((const f32x4*)fg)[lane + 64 * j]; f32x4 v = o[lane + 64 * j]; const f32x4 vn = v * rs * g; o[lane + 64 * j] = dry ? v : vn; }
    }
}


#define XB_TMO      128
#define XB_XCNT(j)  (256  + 64 * (j))
#define XB_XSUB(j)  (1280 + 64 * (j))
#define XB_XGEN(j)  (2304 + 64 * (j))
#define XB_TOP      3328
#define XB_TOPGEN   3392
#define XCD_BAR_WORDS 3456
#define XB_SPIN_CAP (1u << 20)
__device__ __forceinline__ unsigned xb_ld(unsigned* p)              { return __hip_atomic_load(p, __ATOMIC_RELAXED, __HIP_MEMORY_SCOPE_AGENT); }
__device__ __forceinline__ unsigned xb_add(unsigned* p, unsigned v) { return __hip_atomic_fetch_add(p, v, __ATOMIC_RELAXED, __HIP_MEMORY_SCOPE_AGENT); }
__device__ __forceinline__ unsigned xb_xcc_id() { return (unsigned)__builtin_amdgcn_s_getreg((3 << 11) | 20) & 0xFu; }
#define XB_SPIN(cond, bar) do { unsigned _sp = 0; while (cond) { __builtin_amdgcn_s_sleep(1); \
    if ((++_sp & 255u) == 0u) { if (xb_ld(&(bar)[XB_TMO])) break; if (_sp > XB_SPIN_CAP) { atomicAdd(&(bar)[XB_TMO], 1u); break; } } } } while (0)
struct XcdBarrier { unsigned* bar; unsigned x; volatile LAS unsigned* st; };
__device__ __forceinline__ XcdBarrier xcd_barrier_post(unsigned* bar, volatile LAS unsigned* st) {
    XcdBarrier b; b.bar = bar; b.x = xb_xcc_id(); b.st = st;
    if (threadIdx.x == 0) (void)xb_add(&bar[XB_XCNT(b.x)], 1u);
    return b;
}
__device__ __forceinline__ void xcd_barrier_complete(unsigned* bar, unsigned x, unsigned& nloc, unsigned& nx) {
    const unsigned G = gridDim.x * gridDim.y * gridDim.z;
    unsigned sum, cnt, mine, sp = 0u;
    for (;;) {
        sum = 0u; cnt = 0u; mine = 0u;
#pragma unroll
        for (unsigned j = 0; j < 16; ++j) { const unsigned c = xb_ld(&bar[XB_XCNT(j)]); sum += c; cnt += (c > 0u) ? 1u : 0u; mine = (j == x) ? c : mine; }
        if (sum == G) break;
        __builtin_amdgcn_s_sleep(1);
        if ((++sp & 255u) == 0u) { if (xb_ld(&bar[XB_TMO])) break; if (sp > XB_SPIN_CAP) { atomicAdd(&bar[XB_TMO], 1u); break; } }
    }
    nloc = mine > 0u ? mine : 1u; nx = cnt > 0u ? cnt : 1u;
}
__device__ __forceinline__ void xcd_barrier(const XcdBarrier& b) {
    asm volatile("s_waitcnt vmcnt(0)" ::: "memory");
    __syncthreads();
    if (threadIdx.x == 0) {
        unsigned* bar = b.bar;
        __builtin_amdgcn_s_waitcnt(0);
        unsigned nloc = b.st[0], nx = b.st[1];
        if (nloc == 0u) { xcd_barrier_complete(bar, b.x, nloc, nx); b.st[0] = nloc; b.st[1] = nx; }
        const unsigned old = xb_add(&bar[XB_XSUB(b.x)], 1u);
        const unsigned gen = old / nloc;
        if (old + 1u == (gen + 1u) * nloc) {
            __builtin_amdgcn_fence(__ATOMIC_RELEASE, "agent");
            asm volatile("s_waitcnt vmcnt(0)" ::: "memory");
            const unsigned og = xb_add(&bar[XB_TOP], 1u);
            const unsigned tg = og / nx;
            if (og + 1u == (tg + 1u) * nx) xb_add(&bar[XB_TOPGEN], 1u);
            else XB_SPIN(xb_ld(&bar[XB_TOPGEN]) == tg, bar);
            __builtin_amdgcn_fence(__ATOMIC_ACQUIRE, "agent");
            xb_add(&bar[XB_XGEN(b.x)], 1u);
            asm volatile("s_waitcnt vmcnt(0)" ::: "memory");
        } else {
            XB_SPIN(xb_ld(&bar[XB_XGEN(b.x)]) == gen, bar);
            __builtin_amdgcn_fence(__ATOMIC_ACQUIRE, "agent");
            asm volatile("s_waitcnt vmcnt(0)" ::: "memory");
        }
    }
    __syncthreads();
}
#ifndef REPMASK
#define REPMASK 0
#endif
#ifndef PROBEVAR
#define PROBEVAR 0
#endif
#ifndef XSYNC
#define XSYNC 0
#endif
#ifndef DUPMASK
#define DUPMASK 0
#endif
#ifndef ONLYMODE
#define ONLYMODE 0
#endif
#ifndef SKIPM
#define SKIPM 0
#endif
__global__ void __launch_bounds__(512, 2) fwd_kernel(Args args) {
    extern __shared__ __attribute__((aligned(16))) unsigned char lds[];
    cg::grid_group grid = cg::this_grid();
    const int G = gridDim.x, bx = blockIdx.x;
    const int lo = args.ph_lo, hi = args.ph_hi;
    {
        unsigned long long* tb = (unsigned long long*)(lds + 131072);
        if (threadIdx.x < 35) tb[threadIdx.x] = (unsigned long long)args.in[threadIdx.x];
        __syncthreads();
    }
    Ctx a; a.ws = args.ws; a.out = args.out; a.tab = (const unsigned*)(lds + 131072);
    volatile LAS unsigned* bst = (volatile LAS unsigned*)((LAS unsigned char*)lds + 131072 + 2048);
    if (threadIdx.x < 2) bst[threadIdx.x] = 0u;
    __syncthreads();
    const XcdBarrier xbar = xcd_barrier_post((unsigned*)(args.ws + WS_BAR), bst);
#define IN(k) (lo <= (k) && (k) < hi)
#define PASSES(k) _Pragma("unroll 1") for (int pass = ((REPMASK >> (k)) & 1) ? 0 : 1; pass < 2; ++pass)
#define SEAM(k) do { if (IN(k) && IN((k) + 1)) { if (lo < 0) grid.sync(); else xcd_barrier(xbar); } } while (0)
#define RUN_GEMM(MODE, AP, LDA, BP, NN, KK, EP0, EP1) do { if (ONLYMODE != 0 && ONLYMODE != MODE) break; __syncthreads(); pg8::Gemm g{(const bf16_t*)(AP), (const bf16_t*)(BP), LDA, T, NN, KK}; \
        pg8::StaticOrder S; S.init(T, NN, G, bx); Epi<MODE> E{a.ws, a.out, EP0, EP1, (int)dry}; pg8::gemm_phase<Epi<MODE>, pg8::StaticOrder>((LAS unsigned char*)lds, g, S, E); } while (0)
    if (IN(0)) PASSES(0) { if (!(SKIPM & 1)) phase0(a, lds); }
    SEAM(0);
#if XSYNC
    for (int i = 0; i < XSYNC; ++i) grid.sync();
#endif
    if (IN(1)) PASSES(1) { const bool dry = pass == 0; if (!(SKIPM & 1024)) RUN_GEMM(1, a.ws + WS_XB, DM, a.ws + WS_WIN, PW, DM, a.in(11), nullptr); if (!(SKIPM & 1)) dt_phase(a); }
    SEAM(1);
    if (IN(2)) PASSES(2) { if (!(SKIPM & 2)) { lora_prep(a); conv_prepass(a); } }
    SEAM(2);
    if (IN(3)) {
#if DUPMASK & 1
        for (int u = bx; u < NBP * NH; u += G) ssd_prompt_unit(a, u >> 5, u & 31, lds, true);
#endif
#if DUPMASK & 2
        for (int u = bx; u < NBS * 4; u += G) ssd_sample_unit(a, u >> 2, u & 3, lds, true);
#endif
        if (!(SKIPM & 4)) for (int u = bx; u < NBP * NH; u += G) ssd_prompt_unit(a, u >> 5, u & 31, lds, false);
        if (!(SKIPM & 8)) for (int u = bx; u < NBS * 4; u += G) ssd_sample_unit(a, u >> 2, u & 3, lds, false);
    }
    SEAM(3);
    if (IN(4)) { const bool dry = false;
        if (!(SKIPM & 1024)) RUN_GEMM(2, a.ws + WS_LA, 256, a.ws + WS_WLO, 3072, 256, a.in(17), a.in(19));
        { const int skip = (G > 96) ? 48 : 0;
          if (bx >= skip && !(SKIPM & 16)) ya_norm(a, dry, (bx - skip) * 512 + (int)threadIdx.x, (G - skip) * 512); } }
    SEAM(4);
    if (IN(5)) PASSES(5) { if (!(SKIPM & 32)) rwkv_scalars(a); }
    SEAM(5);
    if (IN(6)) {
#if DUPMASK & 16
        for (int u = bx; u < NBS * 16; u += G) rwkv_sample_unit(a, u, lds);
#endif
#if DUPMASK & 32
        for (int u = bx; u < NBP * 16 * 2; u += G) rwkv_prompt_unit<PROBEVAR>(a, u, lds);
#endif
        if (!(SKIPM & 32)) for (int u = bx; u < NBS * 16; u += G) rwkv_sample_unit(a, u, lds);
        if (!(SKIPM & 64)) for (int u = bx; u < NBP * 16 * 2; u += G) rwkv_prompt_unit(a, u, lds);
    }
    SEAM(6);
    if (IN(7)) { const bool dry = false;
        if (!(SKIPM & 1024)) RUN_GEMM(3, (const bf16_t*)(a.ws + WS_PROJ) + PC_Z, PW, a.ws + WS_WA, DM, DI, nullptr, nullptr);
        { const int skip = (G > 32) ? 16 : 0;
          if (bx >= skip) { if (!(SKIPM & 128)) rwkv_post(a, dry, (bx - skip) * 8 + (int)(threadIdx.x >> 6), (G - skip) * 8);
                            if (!(SKIPM & 1)) tr_run(a, lds, TR_EARLY, TR_ALL, (bx - skip) * 8 + (int)(threadIdx.x >> 6), (G - skip) * 8); } } }
    SEAM(7);
    if (IN(8)) PASSES(8) { const bool dry = pass == 0; if (!(SKIPM & 1024)) RUN_GEMM(4, (const bf16_t*)(a.ws + WS_PROJ) + PC_YB, PW, a.ws + WS_WB, DM, DM, nullptr, nullptr); }
    SEAM(8);
    if (IN(9)) PASSES(9) { const bool dry = pass == 0; if (!(SKIPM & 1024)) RUN_GEMM(5, a.ws + WS_M, DM, a.ws + WS_WOUT, DM, DM, a.in(0), a.in(1)); }
    SEAM(9);
    if (IN(10)) PASSES(10) { const bool dry = pass == 0; if (!(SKIPM & 1024)) RUN_GEMM(6, a.ws + WS_X1B, DM, a.ws + WS_WUP, 5632, DM, nullptr, nullptr); }
    SEAM(10);
    if (IN(11)) PASSES(11) { if (!(SKIPM & 256)) glu_phase(a); }
    SEAM(11);
    if (IN(12)) PASSES(12) { const bool dry = pass == 0; if (!(SKIPM & 1024)) RUN_GEMM(7, a.ws + WS_ACT, DFF, a.ws + WS_WDN, DM, DFF, nullptr, nullptr); }
    SEAM(12);
    if (IN(13)) PASSES(13) { const bool dry = pass == 0; if (!(SKIPM & 512)) final_phase(a, dry); }
#undef IN
#undef PASSES
#undef SEAM
#undef RUN_GEMM
}

#ifndef MK_SPLIT
#define MK_SPLIT 0
#endif
extern "C" void kernel_launch(void* const* d_in, const int* in_sizes, int n_in, void* d_out, int out_size, void* d_ws, size_t ws_size, hipStream_t stream) {
    static int grid = 0;
    if (grid == 0) {
        if (n_in != 35 || (size_t)out_size != O_END || ws_size < WS_END) { fprintf(stderr, "kernel_launch: unexpected shapes: n_in %d out %d ws %zu\n", n_in, out_size, ws_size); grid = -1; return; }
        int dev = 0, cus = 0, per_cu = 0;
        hipGetDevice(&dev); hipDeviceGetAttribute(&cus, hipDeviceAttributeMultiprocessorCount, dev);
        hipFuncSetAttribute((const void*)fwd_kernel, hipFuncAttributeMaxDynamicSharedMemorySize, LDS_BYTES);
        hipOccupancyMaxActiveBlocksPerMultiprocessor(&per_cu, (const void*)fwd_kernel, 512, LDS_BYTES);
        if (per_cu < 1) per_cu = 1;
        grid = cus * per_cu;
        (void)hipGetLastError();
    }
    if (grid < 0) return;
    if (hipMemsetAsync((char*)d_ws + WS_BAR, 0, XCD_BAR_WORDS * 4, stream) != hipSuccess) { fprintf(stderr, "kernel_launch: memset failed\n"); return; }
    Args a{};
    for (int i = 0; i < 35; ++i) a.in[i] = (const float*)d_in[i];
    a.out = (float*)d_out; a.ws = (unsigned char*)d_ws; a.rep = REPMASK;
#if MK_SPLIT
    for (int ph = 0; ph < NPHASE; ++ph) { a.ph_lo = ph; a.ph_hi = ph + 1; void* args[] = {&a};
        hipError_t e = hipLaunchCooperativeKernel((const void*)fwd_kernel, dim3(grid), dim3(512), args, LDS_BYTES, stream);
        if (e != hipSuccess) { fprintf(stderr, "launch failed: %s\n", hipGetErrorString(e)); break; } }
#else
    a.ph_lo = 0; a.ph_hi = NPHASE; void* args[] = {&a};
    hipError_t e = hipLaunchCooperativeKernel((const void*)fwd_kernel, dim3(grid), dim3(512), args, LDS_BYTES, stream);
    if (e != hipSuccess) fprintf(stderr, "cooperative launch failed: %s (grid %d)\n", hipGetErrorString(e), grid);
#endif
}
```
